# Optimizing an MI355X kernel written in HIP

```python
import math
import jax, jax.numpy as jnp
from jax import lax
import numpy as np

D_MODEL = 2048
BATCH = 16
SEQ = 2048
DEPTH = 4

N_MEM = 256
BLOCK = 128
RMS_EPS = 1e-6

SWA_WINDOW = 128
SWA_HEADS = 16
SWA_KV_HEADS = 2
SWA_HEAD_DIM = 64
SWA_GROUP = SWA_HEADS // SWA_KV_HEADS
SWA_Q = SWA_HEADS * SWA_HEAD_DIM
SWA_KV = SWA_KV_HEADS * SWA_HEAD_DIM

DIFF_HEADS = 8
DIFF_HEAD_DIM = 64
DIFF_V_DIM = 2 * DIFF_HEAD_DIM
DIFF_QK = DIFF_HEADS * 2 * DIFF_HEAD_DIM
DIFF_V = DIFF_HEADS * DIFF_V_DIM
DIFF_SUBLN_EPS = 1e-5

MEM_HEADS = 4
MEM_HEAD_DIM = 256
MEM_Q = MEM_HEADS * MEM_HEAD_DIM

N_BRANCH = 3
BRANCH_WIDTH = 1024

IN_SIZES = (SWA_Q, SWA_KV, SWA_KV, DIFF_QK, DIFF_QK, DIFF_V, MEM_Q, N_BRANCH * D_MODEL)
D_IN = sum(IN_SIZES)
IN_SPLITS = tuple(int(v) for v in np.cumsum(IN_SIZES)[:-1])

D_FF = 4 * D_MODEL

N_BUCKETS = 32
MAX_DISTANCE = 128
N_BIAS_HEADS = SWA_HEADS + DIFF_HEADS

kernel_name = "hybrid_swa_sink_diffattn_memxattn_gated_trunk"


def rms_norm(x, g, eps=RMS_EPS):
    xf = x.astype(jnp.float32)
    y = xf * lax.rsqrt(jnp.mean(xf * xf, axis=-1, keepdims=True) + eps)
    return (y * g.astype(jnp.float32)).astype(x.dtype)


def t5_bucket(dist):
    max_exact = N_BUCKETS // 2
    n = jnp.maximum(dist, 0)
    nf = jnp.maximum(n, 1).astype(jnp.float32)
    large = max_exact + (jnp.log(nf / max_exact) / math.log(MAX_DISTANCE / max_exact)
                         * (N_BUCKETS - max_exact)).astype(jnp.int32)
    large = jnp.minimum(large, N_BUCKETS - 1)
    return jnp.where(n < max_exact, n, large)


def swa_sink_attention(q, k, v, sinks, bias_table):
    B, S = q.shape[0], q.shape[1]
    nb = S // BLOCK
    qb = q.reshape(B, nb, BLOCK, SWA_KV_HEADS, SWA_GROUP, SWA_HEAD_DIM)
    kb = k.reshape(B, nb, BLOCK, SWA_KV_HEADS, SWA_HEAD_DIM)
    vb = v.reshape(B, nb, BLOCK, SWA_KV_HEADS, SWA_HEAD_DIM)

    def with_prev(t):
        prev = jnp.pad(t, ((0, 0), (1, 0), (0, 0), (0, 0), (0, 0)))[:, :-1]
        return jnp.concatenate([prev, t], axis=2)

    kw, vw = with_prev(kb), with_prev(vb)
    s = jnp.einsum('bnqhgd,bnkhd->bnhgqk', qb, kw,
                   preferred_element_type=jnp.float32) * (SWA_HEAD_DIM ** -0.5)

    qi = jnp.arange(BLOCK)[:, None]
    kj = jnp.arange(2 * BLOCK)[None, :]
    dist = qi + BLOCK - kj
    blk = jnp.arange(nb)[:, None, None]
    valid = (dist >= 0) & (dist < SWA_WINDOW) & (blk * BLOCK - BLOCK + kj >= 0)

    bias = bias_table[:, :SWA_HEADS][t5_bucket(dist)].astype(jnp.float32)
    bias = bias.reshape(BLOCK, 2 * BLOCK, SWA_KV_HEADS, SWA_GROUP).transpose(2, 3, 0, 1)
    s = jnp.where(valid[None, :, None, None], s + bias[None, None], -jnp.inf)

    sink = sinks.astype(jnp.float32).reshape(SWA_KV_HEADS, SWA_GROUP)[None, None, :, :, None, None]
    m = jnp.maximum(jnp.max(s, axis=-1, keepdims=True), sink)
    p = jnp.exp(s - m)
    denom = jnp.sum(p, axis=-1, keepdims=True) + jnp.exp(sink - m)
    o = jnp.einsum('bnhgqk,bnkhd->bnqhgd', (p / denom).astype(v.dtype), vw)
    return o.reshape(B, S, SWA_Q)


def diff_attention(q, k, v, lam, lam_init, subln_g, bias_table):
    B, S = q.shape[0], q.shape[1]
    nb = S // BLOCK
    q = q.reshape(B, S, DIFF_HEADS, 2, DIFF_HEAD_DIM)
    k = k.reshape(B, S, DIFF_HEADS, 2, DIFF_HEAD_DIM)
    v = v.reshape(B, S, DIFF_HEADS, DIFF_V_DIM)
    table = bias_table[:, SWA_HEADS:]
    scale = DIFF_HEAD_DIM ** -0.5
    outs = []
    for i in range(nb):
        L = (i + 1) * BLOCK
        q_i = q[:, i * BLOCK:L]
        k_i, v_i = k[:, :L], v[:, :L]
        s = jnp.einsum('bqhmd,bkhmd->bhmqk', q_i, k_i,
                       preferred_element_type=jnp.float32) * scale
        dist = (i * BLOCK + jnp.arange(BLOCK))[:, None] - jnp.arange(L)[None, :]
        bias = table[t5_bucket(dist)].astype(jnp.float32).transpose(2, 0, 1)
        s = jnp.where(dist >= 0, s + bias[None, :, None], -jnp.inf)
        a = jax.nn.softmax(s, axis=-1)
        a = a[:, :, 0] - lam * a[:, :, 1]
        outs.append(jnp.einsum('bhqk,bkhe->bqhe', a.astype(v.dtype), v_i))
    o = jnp.concatenate(outs, axis=1)
    o = rms_norm(o, subln_g, DIFF_SUBLN_EPS) * (1.0 - lam_init)
    return o.reshape(B, S, DIFF_V)


def memory_attention(q, mem_k, mem_v):
    B, S = q.shape[0], q.shape[1]
    qh = q.reshape(B, S, MEM_HEADS, MEM_HEAD_DIM)
    kh = mem_k.reshape(B, -1, MEM_HEADS, MEM_HEAD_DIM)
    vh = mem_v.reshape(B, -1, MEM_HEADS, MEM_HEAD_DIM)
    s = jnp.einsum('bshd,bmhd->bhsm', qh, kh,
                   preferred_element_type=jnp.float32) * (MEM_HEAD_DIM ** -0.5)
    a = jax.nn.softmax(s, axis=-1)
    o = jnp.einsum('bhsm,bmhd->bshd', a.astype(vh.dtype), vh)
    return o.reshape(B, S, MEM_Q)


def setup_inputs(seed: int = 0) -> dict:
    key = jax.random.key(seed)
    ks = jax.random.split(key, 20)
    nrm = lambda k, shape, s: jax.random.normal(k, shape, jnp.float32) * s
    return {
        "x": nrm(ks[0], (BATCH, SEQ, D_MODEL), 1.0),
        "mem": nrm(ks[1], (BATCH, N_MEM, D_MODEL), 1.0),
        "rel_bias": nrm(ks[2], (N_BUCKETS, N_BIAS_HEADS), 0.5),
        "norm1_g": 1.0 + nrm(ks[3], (DEPTH, D_MODEL), 0.02),
        "w_in": nrm(ks[4], (DEPTH, D_MODEL, D_IN), D_MODEL ** -0.5),
        "b_gate": nrm(ks[5], (DEPTH, N_BRANCH * D_MODEL), 0.1),
        "swa_sinks": nrm(ks[6], (DEPTH, SWA_HEADS), 0.5),
        "lam_q1": nrm(ks[7], (DEPTH, DIFF_HEAD_DIM), 0.1),
        "lam_k1": nrm(ks[8], (DEPTH, DIFF_HEAD_DIM), 0.1),
        "lam_q2": nrm(ks[9], (DEPTH, DIFF_HEAD_DIM), 0.1),
        "lam_k2": nrm(ks[10], (DEPTH, DIFF_HEAD_DIM), 0.1),
        "diff_subln_g": 1.0 + nrm(ks[11], (DEPTH, DIFF_V_DIM), 0.02),
        "mem_norm_g": 1.0 + nrm(ks[12], (DEPTH, D_MODEL), 0.02),
        "w_mem_kv": nrm(ks[13], (DEPTH, D_MODEL, 2 * MEM_Q), D_MODEL ** -0.5),
        "w_branch": nrm(ks[14], (DEPTH, N_BRANCH, BRANCH_WIDTH, D_MODEL), BRANCH_WIDTH ** -0.5),
        "w_out": nrm(ks[15], (DEPTH, D_MODEL, D_MODEL), D_MODEL ** -0.5),
        "norm2_g": 1.0 + nrm(ks[16], (DEPTH, D_MODEL), 0.02),
        "w_mlp1": nrm(ks[17], (DEPTH, D_MODEL, D_FF), D_MODEL ** -0.5),
        "w_mlp2": nrm(ks[18], (DEPTH, D_FF, D_MODEL), D_FF ** -0.5),
        "final_g": 1.0 + nrm(ks[19], (D_MODEL,), 0.02),
    }


def reference(x, mem, rel_bias, norm1_g, w_in, b_gate, swa_sinks, lam_q1, lam_k1, lam_q2,
              lam_k2, diff_subln_g, mem_norm_g, w_mem_kv, w_branch, w_out, norm2_g,
              w_mlp1, w_mlp2, final_g):
    B, S = x.shape[0], x.shape[1]
    for l in range(DEPTH):
        h = rms_norm(x, norm1_g[l])
        z = jnp.einsum('bsd,de->bse', h, w_in[l])
        q_a, k_a, v_a, q_b, k_b, v_b, q_c, gate = jnp.split(z, IN_SPLITS, axis=-1)

        o_a = swa_sink_attention(q_a, k_a, v_a, swa_sinks[l], rel_bias)

        lam_init = 0.8 - 0.6 * math.exp(-0.3 * l)
        lam = (jnp.exp(jnp.sum(lam_q1[l].astype(jnp.float32) * lam_k1[l].astype(jnp.float32)))
               - jnp.exp(jnp.sum(lam_q2[l].astype(jnp.float32) * lam_k2[l].astype(jnp.float32)))
               + lam_init)
        o_b = diff_attention(q_b, k_b, v_b, lam, lam_init, diff_subln_g[l], rel_bias)

        mem_kv = jnp.einsum('bmd,de->bme', rms_norm(mem, mem_norm_g[l]), w_mem_kv[l])
        mem_k, mem_v = jnp.split(mem_kv, 2, axis=-1)
        o_c = memory_attention(q_c, mem_k, mem_v)

        gates = jax.nn.sigmoid((gate + b_gate[l]).astype(jnp.float32)).astype(x.dtype)
        gates = gates.reshape(B, S, N_BRANCH, D_MODEL)
        merged = None
        for i, o_i in enumerate((o_a, o_b, o_c)):
            term = gates[:, :, i] * jnp.einsum('bsc,cd->bsd', o_i, w_branch[l, i])
            merged = term if merged is None else merged + term
        x = x + jnp.einsum('bsd,de->bse', merged, w_out[l])

        h2 = rms_norm(x, norm2_g[l])
        u = jnp.square(jax.nn.relu(jnp.einsum('bsd,df->bsf', h2, w_mlp1[l])))
        x = x + jnp.einsum('bsf,fd->bsd', u, w_mlp2[l])
    return rms_norm(x, final_g)
```

```cpp
#include <hip/hip_runtime.h>
#include <cstdio>
#include <cstdint>
#ifndef MFMA_DIFF
#define MFMA_DIFF 1
#endif
#ifndef MFMA_SWA
#define MFMA_SWA 1
#endif
#ifndef MFMA_MEM
#define MFMA_MEM 1
#endif

namespace pg8 {
#define PG8_LAS __attribute__((address_space(3)))
typedef unsigned short bf16_t;
typedef short bf16x8 __attribute__((ext_vector_type(8)));
typedef float f32x4 __attribute__((ext_vector_type(4)));
typedef unsigned u32x4 __attribute__((ext_vector_type(4)));
constexpr int BM = 256, BK = 64, HALF = 128, HTB = HALF * BK * 2  , STAGE_BYTES = 8 * HTB, NXCD = 8, WGM = 8;

__host__ __device__ __forceinline__ int lds_byte(int r, int c) { const int st = (r >> 4) * 2 + (c >> 5), rr = r & 15, cc = c & 31, ob = rr * 64 + cc * 2; return st * 1024 + (ob ^ (((ob >> 9) & 1) << 5)); }
__host__ __device__ __forceinline__ void stage_rc(int b, int& R, int& C) { const int st = b / 1024, sb = b % 1024, swz = sb ^ (((sb >> 9) & 1) << 5); R = (st >> 1) * 16 + swz / 64; C = (st & 1) * 32 + (swz % 64) / 2; }
__host__ __device__ __forceinline__ int perm32(int rho) { const int n = rho >> 4, i = rho & 15; return 8 * (i >> 2) + 4 * n + (i & 3); }

struct Unit { int pm, pn, br; };
struct Gemm { const bf16_t* A; const bf16_t* Bt; int K, lda, ldb; long a_br1, a_br2, b_br;
    __device__ __forceinline__ long aoff(int br) const { return br == 0 ? 0l : (br == 1 ? a_br1 : a_br2); } };

struct StaticOrder {
    int nM, nN, nwg, G, c;
    __host__ __device__ void init(int M, int N, int G_, int c_) { nM = M / BM; nN = N / BM; nwg = nM * nN; G = G_; c = c_; }
    __host__ __device__ bool tile(long L, Unit& u) const {
        if (L >= nwg) return false;
        int wgid = (int)L; { const int q = nwg / NXCD, r = nwg % NXCD, xcd = wgid % NXCD, off = wgid / NXCD; wgid = (xcd < r ? xcd * (q + 1) : r * (q + 1) + (xcd - r) * q) + off; }
        const int nig = WGM * nN, gid = wgid / nig, fm = gid * WGM, gsz = (nM - fm) < WGM ? (nM - fm) : WGM;
        u.pm = fm + ((wgid % nig) % gsz); u.pn = (wgid % nig) / gsz; u.br = 0; return true;
    }
    __host__ __device__ bool next(int i, Unit& u) const { return tile((long)i * G + c, u); }
    __device__ __forceinline__ void a_ready(const Unit&) const {}
    __device__ __forceinline__ void done(const Unit&) const {}
};
template <int NBR> struct BranchOrder : StaticOrder {
    __host__ __device__ bool next(int i, Unit& u) const { const int t = i / NBR; if (!tile((long)t * G + c, u)) return false; u.br = i - t * NBR; return true; }
};

__device__ __forceinline__ unsigned cvt_pk_bf16(float lo, float hi) { unsigned r; asm volatile("v_cvt_pk_bf16_f32 %0, %1, %2" : "=v"(r) : "v"(lo), "v"(hi)); return r; }
__device__ __forceinline__ float bf_lo(unsigned w) { return __uint_as_float(w << 16); }
__device__ __forceinline__ float bf_hi(unsigned w) { return __uint_as_float(w & 0xffff0000u); }


struct EpiZ {
    static constexpr bool PERM = true, AFTER_DRAIN = false;
    bf16_t* O; int ldc; const float* bgate; int gate_pn0;
    __device__ __forceinline__ void operator()(const f32x4 (&acc)[2][2][4][2], const Unit& u, int wr, int wc, int fr, int fq) const {
        const int row0 = u.pm * BM + wr * 64 + fr; const int col0 = u.pn * BM + wc * 32 + 8 * fq;
        const bool gate = u.pn >= gate_pn0;
        f32x4 bv[2][2];
#pragma unroll
        for (int bj = 0; bj < 2; ++bj)
#pragma unroll
            for (int n = 0; n < 2; ++n) bv[bj][n] = gate ? *(const f32x4*)(bgate + (col0 - gate_pn0 * BM) + bj * HALF + 4 * n) : (f32x4){0.f, 0.f, 0.f, 0.f};
#pragma unroll
        for (int ai = 0; ai < 2; ++ai)
#pragma unroll
            for (int m = 0; m < 4; ++m) { bf16_t* rowp = O + (size_t)(row0 + ai * HALF + m * 16) * ldc + col0;
#pragma unroll
                for (int bj = 0; bj < 2; ++bj) { f32x4 v0 = acc[ai][bj][m][0], v1 = acc[ai][bj][m][1];
                    if (gate) {
                        v0 = v0 + bv[bj][0]; v1 = v1 + bv[bj][1];
#pragma unroll
                        for (int j = 0; j < 4; ++j) { v0[j] = __builtin_amdgcn_rcpf(1.0f + __builtin_amdgcn_exp2f(-1.4426950408889634f * v0[j])); v1[j] = __builtin_amdgcn_rcpf(1.0f + __builtin_amdgcn_exp2f(-1.4426950408889634f * v1[j])); }
                    }
                    u32x4 w; w.x = cvt_pk_bf16(v0[0], v0[1]); w.y = cvt_pk_bf16(v0[2], v0[3]); w.z = cvt_pk_bf16(v1[0], v1[1]); w.w = cvt_pk_bf16(v1[2], v1[3]);
                    *(u32x4*)(rowp + bj * HALF) = w; } }
    }
};
template <int ACT> struct EpiBf16 {
    static constexpr bool PERM = true, AFTER_DRAIN = false;
    bf16_t* O; int ldc;
    __device__ __forceinline__ void operator()(const f32x4 (&acc)[2][2][4][2], const Unit& u, int wr, int wc, int fr, int fq) const {
        const int row0 = u.pm * BM + wr * 64 + fr; const int col0 = u.pn * BM + wc * 32 + 8 * fq;
#pragma unroll
        for (int ai = 0; ai < 2; ++ai)
#pragma unroll
            for (int m = 0; m < 4; ++m) { bf16_t* rowp = O + (size_t)(row0 + ai * HALF + m * 16) * ldc + col0;
#pragma unroll
                for (int bj = 0; bj < 2; ++bj) { f32x4 v0 = acc[ai][bj][m][0], v1 = acc[ai][bj][m][1];
                    if (ACT == 1) {
#pragma unroll
                        for (int j = 0; j < 4; ++j) { const float a = fmaxf(v0[j], 0.f), b = fmaxf(v1[j], 0.f); v0[j] = a * a; v1[j] = b * b; } }
                    u32x4 w; w.x = cvt_pk_bf16(v0[0], v0[1]); w.y = cvt_pk_bf16(v0[2], v0[3]); w.z = cvt_pk_bf16(v1[0], v1[1]); w.w = cvt_pk_bf16(v1[2], v1[3]);
                    *(u32x4*)(rowp + bj * HALF) = w; } }
    }
};
struct EpiBranch {
    static constexpr bool PERM = true, AFTER_DRAIN = false;
    bf16_t* mrg; int ldm; const bf16_t* gates; int ldg; int gate_br;
    __device__ __forceinline__ void operator()(const f32x4 (&acc)[2][2][4][2], const Unit& u, int wr, int wc, int fr, int fq) const {
        const int row0 = u.pm * BM + wr * 64 + fr; const int col0 = u.pn * BM + wc * 32 + 8 * fq;
        const bool first = (u.br == 0);
#pragma unroll
        for (int ai = 0; ai < 2; ++ai)
#pragma unroll
            for (int m = 0; m < 4; ++m) { const size_t row = (size_t)(row0 + ai * HALF + m * 16);
                bf16_t* mp = mrg + row * ldm + col0; const bf16_t* gp = gates + row * ldg + (size_t)u.br * gate_br + col0;
#pragma unroll
                for (int bj = 0; bj < 2; ++bj) {
                    const u32x4 g = *(const u32x4*)(gp + bj * HALF);
                    u32x4 p = (u32x4){0u, 0u, 0u, 0u}; if (!first) p = *(const u32x4*)(mp + bj * HALF);
                    const f32x4 a0 = acc[ai][bj][m][0], a1 = acc[ai][bj][m][1];
                    u32x4 w;
                    w.x = cvt_pk_bf16(bf_lo(p.x) + bf_lo(g.x) * a0[0], bf_hi(p.x) + bf_hi(g.x) * a0[1]);
                    w.y = cvt_pk_bf16(bf_lo(p.y) + bf_lo(g.y) * a0[2], bf_hi(p.y) + bf_hi(g.y) * a0[3]);
                    w.z = cvt_pk_bf16(bf_lo(p.z) + bf_lo(g.z) * a1[0], bf_hi(p.z) + bf_hi(g.z) * a1[1]);
                    w.w = cvt_pk_bf16(bf_lo(p.w) + bf_lo(g.w) * a1[2], bf_hi(p.w) + bf_hi(g.w) * a1[3]);
                    *(u32x4*)(mp + bj * HALF) = w; } }
    }
};
struct EpiRes {
    static constexpr bool PERM = false, AFTER_DRAIN = false;
    const float* xin; float* xout; int ldc;
    __device__ __forceinline__ void operator()(const f32x4 (&acc)[2][2][4][2], const Unit& u, int wr, int wc, int fr, int fq) const {
        const int row0 = u.pm * BM + wr * 64 + fr, col0 = u.pn * BM + wc * 32 + 4 * fq;
#pragma unroll
        for (int ai = 0; ai < 2; ++ai)
#pragma unroll
            for (int m = 0; m < 4; ++m) { const size_t off = (size_t)(row0 + ai * HALF + m * 16) * ldc + col0;
#pragma unroll
                for (int bj = 0; bj < 2; ++bj)
#pragma unroll
                    for (int n = 0; n < 2; ++n) { const f32x4 b = *(const f32x4*)(xin + off + bj * HALF + n * 16); *(f32x4*)(xout + off + bj * HALF + n * 16) = b + acc[ai][bj][m][n]; } }
    }
};
template <class Epi, class Sched, bool ALIGN_EPI = false, bool SP2 = false>
__device__ __forceinline__ void gemm_phase(PG8_LAS unsigned char* lds, const Gemm g, const Sched& S, const Epi& E, const int tid) {
    const int wid = __builtin_amdgcn_readfirstlane(tid >> 6), lane = tid & 63, wr = wid >> 2, wc = wid & 3, fr = lane & 15, fq = lane >> 4;
    const int K = g.K, nt = K / BK;
    unsigned voffA[2], voffB[2];
#pragma unroll
    for (int i = 0; i < 2; ++i) { int R, C; stage_rc(tid * 16 + i * 8192, R, C); const int Rb = Epi::PERM ? ((R & ~31) + perm32(R & 31)) : R;
        voffA[i] = (unsigned)(R * g.lda + C) * 2u; voffB[i] = (unsigned)(Rb * g.ldb + C) * 2u; }
    const size_t kstep = (size_t)(BK * 2);
    const size_t hstepA = (size_t)HALF * g.lda * 2, hstepB = (size_t)HALF * g.ldb * 2;
    const size_t tstepA = 2 * hstepA, tstepB = 2 * hstepB;
    const unsigned ldsw = (unsigned)wid * 1024u;
    const int aoff = lds_byte(wr * 64 + fr, fq * 8), boff = lds_byte(wc * 32 + fr, fq * 8);
#define PG8_SA(b, h) (((b) * 2 + (h)) * HTB)
#define PG8_SB(b, h) ((4 + (b) * 2 + (h)) * HTB)
#define PG8_STAGE(bufoff, gbase, voff) do { _Pragma("unroll") for (int _i = 0; _i < 2; ++_i) \
        __builtin_amdgcn_global_load_lds((const unsigned*)((const char*)(gbase) + (voff)[_i]), (PG8_LAS unsigned*)(lds + (bufoff) + ldsw + _i * 8192), 16, 0, 0); } while (0)
#define PG8_LDA(dst, b, h) do { _Pragma("unroll") for (int m = 0; m < 4; ++m) _Pragma("unroll") for (int k = 0; k < 2; ++k) dst[m][k] = *(const PG8_LAS bf16x8*)(lds + PG8_SA(b, h) + aoff + m * 2048 + k * 1024); } while (0)
#define PG8_LDB(dst, b, h) do { _Pragma("unroll") for (int n = 0; n < 2; ++n) _Pragma("unroll") for (int k = 0; k < 2; ++k) dst[n][k] = *(const PG8_LAS bf16x8*)(lds + PG8_SB(b, h) + boff + n * 2048 + k * 1024); } while (0)
#define PG8_MMA(ai, bj, At, Bt) do { __builtin_amdgcn_s_setprio(1); _Pragma("unroll") for (int m = 0; m < 4; ++m) _Pragma("unroll") for (int n = 0; n < 2; ++n) _Pragma("unroll") for (int k = 0; k < 2; ++k) \
        acc[ai][bj][m][n] = __builtin_amdgcn_mfma_f32_16x16x32_bf16(Bt[n][k], At[m][k], acc[ai][bj][m][n], 0, 0, 0); __builtin_amdgcn_s_setprio(0); } while (0)
#define PG8_WAIT_V(n) asm volatile("s_waitcnt vmcnt(" #n ")" ::: "memory")
#define PG8_WAIT_L(n) asm volatile("s_waitcnt lgkmcnt(" #n ")" ::: "memory")
#define PG8_BAR __builtin_amdgcn_s_barrier()
#define PG8_SCHED __builtin_amdgcn_sched_barrier(0)
    Unit cur, nxt; int ui = 0;
    if (!S.next(0, cur)) return;
    f32x4 acc[2][2][4][2];
#pragma unroll
    for (int a = 0; a < 2; ++a)
#pragma unroll
        for (int b = 0; b < 2; ++b)
#pragma unroll
            for (int m = 0; m < 4; ++m)
#pragma unroll
                for (int n = 0; n < 2; ++n) acc[a][b][m][n] = (f32x4){0.f, 0.f, 0.f, 0.f};
    bf16x8 At[4][2], B0[2][2], B1[2][2];
    const char* cA = (const char*)g.A + (size_t)cur.pm * tstepA + g.aoff(cur.br); const char* cB = (const char*)g.Bt + (size_t)cur.pn * tstepB + (long)cur.br * g.b_br;
    S.a_ready(cur);
    if constexpr (SP2) {
        PG8_STAGE(PG8_SB(0, 0), cB, voffB); PG8_STAGE(PG8_SB(0, 1), cB + hstepB, voffB); PG8_STAGE(PG8_SA(0, 0), cA, voffA); PG8_STAGE(PG8_SA(0, 1), cA + hstepA, voffA);
        if (wr == 1) PG8_BAR;
        PG8_WAIT_V(2); PG8_BAR;
        PG8_STAGE(PG8_SB(1, 0), cB + kstep, voffB); PG8_STAGE(PG8_SA(1, 0), cA + kstep, voffA); PG8_STAGE(PG8_SB(1, 1), cB + hstepB + kstep, voffB);
        PG8_WAIT_V(6); PG8_BAR;
    } else {
        PG8_STAGE(PG8_SB(0, 0), cB, voffB); PG8_STAGE(PG8_SA(0, 0), cA, voffA); PG8_STAGE(PG8_SB(0, 1), cB + hstepB, voffB); PG8_STAGE(PG8_SA(0, 1), cA + hstepA, voffA);
        if (wr == 1) PG8_BAR;
        PG8_WAIT_V(4); PG8_BAR;
        PG8_STAGE(PG8_SB(1, 0), cB + kstep, voffB); PG8_STAGE(PG8_SA(1, 0), cA + kstep, voffA); PG8_STAGE(PG8_SB(1, 1), cB + hstepB + kstep, voffB);
        PG8_WAIT_V(6); PG8_BAR;
    }
    for (;;) {
        const bool has_next = S.next(ui + 1, nxt);
        const char* nA = has_next ? (const char*)g.A + (size_t)nxt.pm * tstepA + g.aoff(nxt.br) : cA; const char* nB = has_next ? (const char*)g.Bt + (size_t)nxt.pn * tstepB + (long)nxt.br * g.b_br : cB;
        for (int t = 0; t < nt; t += 2) {
            const bool last = (t == nt - 2);
            const char* a1 = cA + (size_t)(t + 1) * kstep;
            const char* a2 = last ? nA : cA + (size_t)(t + 2) * kstep; const char* b2 = last ? nB : cB + (size_t)(t + 2) * kstep;
            const char* a3 = a2 + kstep; const char* b3 = b2 + kstep;
            if (last && has_next) S.a_ready(nxt);
            if constexpr (SP2) {
            PG8_LDB(B0, 0, 0); PG8_LDB(B1, 0, 1); PG8_SCHED; PG8_LDA(At, 0, 0); PG8_STAGE(PG8_SA(1, 1), a1 + hstepA, voffA);
            PG8_WAIT_V(8); PG8_WAIT_L(0); PG8_BAR; PG8_MMA(0, 0, At, B0); PG8_MMA(0, 1, At, B1); PG8_BAR; PG8_SCHED;
            PG8_LDA(At, 0, 1); PG8_STAGE(PG8_SB(0, 0), b2, voffB); PG8_STAGE(PG8_SB(0, 1), b2 + hstepB, voffB); PG8_STAGE(PG8_SA(0, 0), a2, voffA);
            PG8_WAIT_V(8); PG8_WAIT_L(0); PG8_BAR; PG8_MMA(1, 0, At, B0); PG8_MMA(1, 1, At, B1); PG8_BAR; PG8_SCHED;
            PG8_LDB(B0, 1, 0); PG8_LDB(B1, 1, 1); PG8_SCHED; PG8_LDA(At, 1, 0); PG8_STAGE(PG8_SA(0, 1), a2 + hstepA, voffA);
            PG8_WAIT_V(8); PG8_WAIT_L(0); PG8_BAR; PG8_MMA(0, 0, At, B0); PG8_MMA(0, 1, At, B1); PG8_BAR; PG8_SCHED;
            PG8_LDA(At, 1, 1); PG8_STAGE(PG8_SB(1, 0), b3, voffB); PG8_STAGE(PG8_SB(1, 1), b3 + hstepB, voffB); PG8_STAGE(PG8_SA(1, 0), a3, voffA);
            PG8_WAIT_V(8); PG8_WAIT_L(0); PG8_BAR; PG8_MMA(1, 0, At, B0); PG8_MMA(1, 1, At, B1); PG8_BAR; PG8_SCHED;
            } else {
            PG8_LDB(B0, 0, 0); PG8_SCHED; PG8_LDA(At, 0, 0); PG8_STAGE(PG8_SA(1, 1), a1 + hstepA, voffA);
            PG8_WAIT_L(8); PG8_BAR; PG8_WAIT_L(0); PG8_MMA(0, 0, At, B0); PG8_BAR; PG8_SCHED;
            PG8_LDB(B1, 0, 1); PG8_STAGE(PG8_SB(0, 0), b2, voffB);
            PG8_BAR; PG8_WAIT_L(0); PG8_MMA(0, 1, At, B1); PG8_BAR;
            PG8_LDA(At, 0, 1); PG8_STAGE(PG8_SA(0, 0), a2, voffA);
            PG8_BAR; PG8_WAIT_L(0); PG8_MMA(1, 0, At, B0); PG8_BAR; PG8_SCHED;
            PG8_STAGE(PG8_SB(0, 1), b2 + hstepB, voffB);
            PG8_WAIT_V(6); PG8_BAR; PG8_MMA(1, 1, At, B1); PG8_BAR;
            PG8_LDB(B0, 1, 0); PG8_SCHED; PG8_LDA(At, 1, 0); PG8_STAGE(PG8_SA(0, 1), a2 + hstepA, voffA);
            PG8_WAIT_L(8); PG8_BAR; PG8_WAIT_L(0); PG8_MMA(0, 0, At, B0); PG8_BAR; PG8_SCHED;
            PG8_LDB(B1, 1, 1); PG8_STAGE(PG8_SB(1, 0), b3, voffB);
            PG8_BAR; PG8_WAIT_L(0); PG8_MMA(0, 1, At, B1); PG8_BAR;
            PG8_LDA(At, 1, 1); PG8_STAGE(PG8_SA(1, 0), a3, voffA);
            PG8_BAR; PG8_WAIT_L(0); PG8_MMA(1, 0, At, B0); PG8_BAR; PG8_SCHED;
            PG8_STAGE(PG8_SB(1, 1), b3 + hstepB, voffB);
            PG8_WAIT_V(6); PG8_BAR; PG8_MMA(1, 1, At, B1); PG8_BAR;
            }
        }
        if constexpr (ALIGN_EPI) { if (wr == 0) PG8_BAR; }
        if constexpr (!Epi::AFTER_DRAIN) { E(acc, cur, wr, wc, fr, fq); S.done(cur); }
        if (!has_next) break;
#pragma unroll
        for (int a = 0; a < 2; ++a)
#pragma unroll
            for (int b = 0; b < 2; ++b)
#pragma unroll
                for (int m = 0; m < 4; ++m)
#pragma unroll
                    for (int n = 0; n < 2; ++n) acc[a][b][m][n] = (f32x4){0.f, 0.f, 0.f, 0.f};
        cur = nxt; cA = nA; cB = nB; ++ui;
        if constexpr (ALIGN_EPI) { if (wr == 1) PG8_BAR; }
    }
    PG8_WAIT_V(0);
    if constexpr (!ALIGN_EPI) { if (wr == 0) PG8_BAR; }
    PG8_BAR;
    if constexpr (Epi::AFTER_DRAIN) { E.fused(acc, cur, wr, wc, fr, fq, lds, wid, lane); S.done(cur); }
#undef PG8_SA
#undef PG8_SB
#undef PG8_STAGE
#undef PG8_LDA
#undef PG8_LDB
#undef PG8_MMA
#undef PG8_WAIT_V
#undef PG8_WAIT_L
#undef PG8_BAR
#undef PG8_SCHED
}
}
#define GAS __attribute__((address_space(1)))
#define LAS __attribute__((address_space(3)))
typedef unsigned short bf16;
typedef unsigned v4u __attribute__((ext_vector_type(4)));
typedef float f32x4 __attribute__((ext_vector_type(4)));
typedef short bf16x8 __attribute__((ext_vector_type(8)));
typedef GAS unsigned gu32;
typedef GAS unsigned long long gu64;
#define RLX_AGENT __ATOMIC_RELAXED, __HIP_MEMORY_SCOPE_AGENT
#define LDS_WAIT() asm volatile("s_waitcnt lgkmcnt(0)" ::: "memory")
#define VM_WAIT() asm volatile("s_waitcnt vmcnt(0)" ::: "memory")
__device__ __forceinline__ unsigned long long rt() { return __builtin_amdgcn_s_memrealtime(); }
__device__ __forceinline__ unsigned f2bf(float f) { unsigned u = __builtin_bit_cast(unsigned, f); return (u + 0x7fffu + ((u >> 16) & 1u)) >> 16; }
__device__ __forceinline__ unsigned pk2(float lo, float hi) { return f2bf(lo) | (f2bf(hi) << 16); }

#define XB_TMO      128
#define XB_XCNT(j)  (256  + 64 * (j))
#define XB_XSUB(j)  (1280 + 64 * (j))
#define XB_XGEN(j)  (2304 + 64 * (j))
#define XB_TOP      3328
#define XB_TOPGEN   3392
#define XCD_BAR_WORDS 3456
#define XB_SPIN_CAP (1u << 18)

__device__ __forceinline__ unsigned xb_ld(unsigned* p)              { return __hip_atomic_load(p, __ATOMIC_RELAXED, __HIP_MEMORY_SCOPE_AGENT); }
__device__ __forceinline__ unsigned xb_add(unsigned* p, unsigned v) { return __hip_atomic_fetch_add(p, v, __ATOMIC_RELAXED, __HIP_MEMORY_SCOPE_AGENT); }
__device__ __forceinline__ unsigned xb_xcc_id() { return (unsigned)__builtin_amdgcn_s_getreg((3 << 11) | 20) & 0xFu; }
#define XB_SPIN(cond, bar) do { unsigned _sp = 0; while (cond) { __builtin_amdgcn_s_sleep(1); \
    if ((++_sp & 255u) == 0u) { if (xb_ld(&(bar)[XB_TMO])) break; if (_sp > XB_SPIN_CAP) { atomicAdd(&(bar)[XB_TMO], 1u); break; } } } } while (0)

struct XcdBarrier {
    unsigned* bar; unsigned x;
    volatile LAS unsigned* st;
};

__device__ __forceinline__ XcdBarrier xcd_barrier_post(unsigned* bar, volatile LAS unsigned* st) {
    XcdBarrier b; b.bar = bar; b.x = xb_xcc_id(); b.st = st;
    if (threadIdx.x == 0) (void)xb_add(&bar[XB_XCNT(b.x)], 1u);
    return b;
}
__device__ __forceinline__ void xcd_barrier_complete(unsigned* bar, unsigned x, unsigned& nloc, unsigned& nx) {
    const unsigned G = gridDim.x * gridDim.y * gridDim.z;
    unsigned sum, cnt, mine, sp = 0u;
    for (;;) {
        sum = 0u; cnt = 0u; mine = 0u;
#pragma unroll
        for (unsigned j = 0; j < 16; ++j) { const unsigned c = xb_ld(&bar[XB_XCNT(j)]); sum += c; cnt += (c > 0u) ? 1u : 0u; mine = (j == x) ? c : mine; }
        if (sum == G) break;
        __builtin_amdgcn_s_sleep(1);
        if ((++sp & 255u) == 0u) { if (xb_ld(&bar[XB_TMO])) break; if (sp > XB_SPIN_CAP) { atomicAdd(&bar[XB_TMO], 1u); break; } }
    }
    nloc = mine > 0u ? mine : 1u; nx = cnt > 0u ? cnt : 1u;
}

__device__ __forceinline__ void xcd_barrier(const XcdBarrier& b) {
    asm volatile("s_waitcnt vmcnt(0)" ::: "memory");
    __syncthreads();
    if (threadIdx.x == 0) {
        unsigned* bar = b.bar;
        __builtin_amdgcn_s_waitcnt(0);
        unsigned nloc = b.st[0], nx = b.st[1];
        if (nloc == 0u) { xcd_barrier_complete(bar, b.x, nloc, nx); b.st[0] = nloc; b.st[1] = nx; }
        const unsigned old = xb_add(&bar[XB_XSUB(b.x)], 1u);
        const unsigned gen = old / nloc;
        if (old + 1u == (gen + 1u) * nloc) {
            __builtin_amdgcn_fence(__ATOMIC_RELEASE, "agent");
            asm volatile("s_waitcnt vmcnt(0)" ::: "memory");
            const unsigned og = xb_add(&bar[XB_TOP], 1u);
            const unsigned tg = og / nx;
            if (og + 1u == (tg + 1u) * nx) xb_add(&bar[XB_TOPGEN], 1u);
            else XB_SPIN(xb_ld(&bar[XB_TOPGEN]) == tg, bar);
            __builtin_amdgcn_fence(__ATOMIC_ACQUIRE, "agent");
            xb_add(&bar[XB_XGEN(b.x)], 1u);
            asm volatile("s_waitcnt vmcnt(0)" ::: "memory");
        } else {
            XB_SPIN(xb_ld(&bar[XB_XGEN(b.x)]) == gen, bar);
            __builtin_amdgcn_fence(__ATOMIC_ACQUIRE, "agent");
            asm volatile("s_waitcnt vmcnt(0)" ::: "memory");
        }
    }
    __syncthreads();
}

constexpr int NWAVES = 8;
constexpr int BATCH = 16, SEQ = 2048, DM = 2048, DEPTH = 4, NMEM = 256;
constexpr int T = BATCH * SEQ, TM = BATCH * NMEM;
constexpr int DIN = 11520, DFF = 8192, BW = 1024;
constexpr int C_QA = 0, C_KA = 1024, C_VA = 1152, C_QB = 1280, C_KB = 2304, C_VB = 3328, C_QC = 4352, C_GATE = 5376;
constexpr float LOG2E = 1.4426950408889634f;
constexpr float QS_A = 0.125f * LOG2E, QS_C = 0.0625f * LOG2E;
constexpr float RMS_EPS = 1e-6f, SUBLN_EPS = 1e-5f;

constexpr size_t MiB = 1u << 20;
constexpr size_t WS_CTL = 0, CTL_ZERO_BYTES = 1 * MiB;
constexpr size_t WS_TAB = 1 * MiB;
constexpr size_t WS_WIN = 2 * MiB, WS_WMEM = 47 * MiB, WS_WBR = 55 * MiB, WS_WOUT = 67 * MiB, WS_W1 = 75 * MiB, WS_W2 = 107 * MiB;
constexpr size_t WS_Z = 140 * MiB;
constexpr size_t WS_H = 860 * MiB;
constexpr size_t WS_HM = 988 * MiB;
constexpr size_t WS_MKV = 1004 * MiB;
constexpr size_t WS_END = 1020 * MiB;
static_assert(WS_WIN + (size_t)DIN * DM * 2 <= WS_WMEM && WS_WMEM + (size_t)2048 * DM * 2 <= WS_WBR && WS_WBR + (size_t)3 * DM * BW * 2 <= WS_WOUT && WS_WOUT + (size_t)DM * DM * 2 <= WS_W1 &&
              WS_W1 + (size_t)DFF * DM * 2 <= WS_W2 && WS_W2 + (size_t)DM * DFF * 2 <= WS_Z && WS_Z + (size_t)T * DIN * 2 <= WS_H && WS_H + (size_t)T * DM * 2 <= WS_HM &&
              WS_HM + (size_t)TM * DM * 2 <= WS_MKV && WS_MKV + (size_t)TM * 2048 * 2 <= WS_END, "d_ws map");
constexpr int CW_BAR = 4096;
constexpr int TAB_A = 0, TAB_B = 2048, TAB_LAM = 3072;

constexpr int RING_OFF = 0, RING_BYTES = 131072;
constexpr int LDSCTL_OFF = RING_BYTES, MISC_OFF = LDSCTL_OFF + 320;
constexpr int LDS_BYTES = 147456;

namespace att {
using bf16x8 = __attribute__((ext_vector_type(8))) short;
using s16x4  = __attribute__((ext_vector_type(4))) short;
using f32x16 = __attribute__((ext_vector_type(16))) float;
using u32x4  = __attribute__((ext_vector_type(4))) unsigned;
#define ATT_SBAR() __builtin_amdgcn_sched_barrier(0)
constexpr float THR2 = 8.0f;
__device__ __forceinline__ int crow(int r, int hi) { return (r & 3) + 8 * (r >> 2) + 4 * hi; }
__device__ __forceinline__ unsigned cvtpk(float lo, float hi) { unsigned r; asm volatile("v_cvt_pk_bf16_f32 %0, %1, %2" : "=v"(r) : "v"(lo), "v"(hi)); return r; }
template <int DK> __device__ __forceinline__ int kswz(int row, int ch) {
    if (DK == 64) return row * 128 + ((ch ^ ((row >> 1) & 7)) << 4);
    else return row * (DK * 2) + ((ch ^ (row & 15)) << 4);
}
template <int NDB> __device__ __forceinline__ int v_st(int k, int c) { const int kk = (k & ~0xC) | ((k & 4) << 1) | ((k & 8) >> 1); return ((kk >> 3) * NDB + (c >> 5)) * 512 + ((kk & 7) * 32 + (c & 31)) * 2; }
__device__ __forceinline__ int v_rd_base(int lane) { return ((lane & 3) << 3) | (((lane >> 2) & 3) << 6) | (((lane >> 4) & 1) << 5) | (((lane >> 5) & 1) << 8); }
template <int OFF> __device__ __forceinline__ s16x4 tr_read(int vb) { s16x4 r; asm volatile("ds_read_b64_tr_b16 %0, %1 offset:%2" : "=&v"(r) : "v"(vb), "i"(OFF) : "memory"); return r; }

template <int W> struct TileRegs { u32x4 v[(64 * W / 8) / 512]; };
template <int W> __device__ __forceinline__ void tile_load(TileRegs<W>& R, const bf16* g, size_t ld, int tid) {
    constexpr int CPR = W / 8, N = (64 * CPR) / 512;
#pragma unroll
    for (int i = 0; i < N; ++i) { const int n = tid + 512 * i, row = n / CPR, c = n % CPR; R.v[i] = *(const GAS u32x4*)(g + (size_t)row * ld + c * 8); }
}
template <int DK> __device__ __forceinline__ void tile_write_k(const TileRegs<DK>& R, LAS unsigned char* kb, int tid) {
    constexpr int CPR = DK / 8, N = (64 * CPR) / 512;
#pragma unroll
    for (int i = 0; i < N; ++i) { const int n = tid + 512 * i, row = n / CPR, c = n % CPR; *(LAS u32x4*)(kb + kswz<DK>(row, c)) = R.v[i]; }
}
template <int NDB> __device__ __forceinline__ void tile_write_v(const TileRegs<32 * NDB>& R, LAS unsigned char* vb, int tid) {
    constexpr int CPR = 4 * NDB, N = (64 * CPR) / 512;
#pragma unroll
    for (int i = 0; i < N; ++i) { const int n = tid + 512 * i, row = n / CPR, c = n % CPR; *(LAS u32x4*)(vb + v_st<NDB>(row, c * 8)) = R.v[i]; }
}
template <int DK> __device__ __forceinline__ void qkt(f32x16& p0, f32x16& p1, const LAS unsigned char* kb, const bf16x8* qr, int r32, int hi) {
    p0 = f32x16{}; p1 = f32x16{};
#pragma unroll
    for (int d0 = 0; d0 < DK / 16; ++d0) {
        const bf16x8 b0 = *(const LAS bf16x8*)(kb + kswz<DK>(r32, 2 * d0 + hi));
        const bf16x8 b1 = *(const LAS bf16x8*)(kb + kswz<DK>(32 + r32, 2 * d0 + hi));
        p0 = __builtin_amdgcn_mfma_f32_32x32x16_bf16(b0, qr[d0], p0, 0, 0, 0);
        p1 = __builtin_amdgcn_mfma_f32_32x32x16_bf16(b1, qr[d0], p1, 0, 0, 0); }
}
__device__ __forceinline__ void softmax_tile(f32x16& p0, f32x16& p1, float& m_reg, float& l_reg, float& alpha, bf16x8& pa0, bf16x8& pa1, bf16x8& pa2, bf16x8& pa3) {
    float pmax = p0[0];
#pragma unroll
    for (int r = 1; r < 16; ++r) pmax = fmaxf(pmax, p0[r]);
#pragma unroll
    for (int r = 0; r < 16; ++r) pmax = fmaxf(pmax, p1[r]);
    { auto rr = __builtin_amdgcn_permlane32_swap(__float_as_uint(pmax), __float_as_uint(pmax), false, false); pmax = fmaxf(__uint_as_float(rr[0]), __uint_as_float(rr[1])); }
    if (__builtin_expect(__all(pmax - m_reg <= THR2), 1)) { alpha = 1.f; }
    else { const float mn = fmaxf(m_reg, pmax); alpha = __builtin_amdgcn_exp2f(m_reg - mn); m_reg = mn; }
    float ps = 0.f;
#pragma unroll
    for (int r = 0; r < 16; ++r) { p0[r] = __builtin_amdgcn_exp2f(p0[r] - m_reg); ps += p0[r]; }
#pragma unroll
    for (int r = 0; r < 16; ++r) { p1[r] = __builtin_amdgcn_exp2f(p1[r] - m_reg); ps += p1[r]; }
    { auto rr = __builtin_amdgcn_permlane32_swap(__float_as_uint(ps), __float_as_uint(ps), false, false); ps = __uint_as_float(rr[0]) + __uint_as_float(rr[1]); }
    l_reg = l_reg * alpha + ps;
#define ATT_PK4(P, BASE, OUT) do { unsigned a0 = cvtpk(P[BASE + 0], P[BASE + 1]), a1 = cvtpk(P[BASE + 2], P[BASE + 3]);   \
    unsigned b0 = cvtpk(P[BASE + 4], P[BASE + 5]), b1 = cvtpk(P[BASE + 6], P[BASE + 7]);                              \
    auto r0 = __builtin_amdgcn_permlane32_swap(a0, b0, false, false); auto r1 = __builtin_amdgcn_permlane32_swap(a1, b1, false, false); \
    u32x4 w = {r0[0], r1[0], r0[1], r1[1]}; OUT = __builtin_bit_cast(bf16x8, w); } while (0)
    ATT_PK4(p0, 0, pa0); ATT_PK4(p0, 8, pa1); ATT_PK4(p1, 0, pa2); ATT_PK4(p1, 8, pa3);
#undef ATT_PK4
}
template <int NDB, int D0> __device__ __forceinline__ void pv_one(f32x16& od, int vb, bf16x8 pa0, bf16x8 pa1, bf16x8 pa2, bf16x8 pa3) {
    constexpr int KS = NDB * 1024, HF = NDB * 512, B = D0 * 512;
    const s16x4 l0 = tr_read<B + 0 * KS>(vb), h0 = tr_read<B + 0 * KS + HF>(vb), l1 = tr_read<B + 1 * KS>(vb), h1 = tr_read<B + 1 * KS + HF>(vb);
    const s16x4 l2 = tr_read<B + 2 * KS>(vb), h2 = tr_read<B + 2 * KS + HF>(vb), l3 = tr_read<B + 3 * KS>(vb), h3 = tr_read<B + 3 * KS + HF>(vb);
    asm volatile("s_waitcnt lgkmcnt(0)" ::: "memory"); ATT_SBAR();
#define ATT_PK(L, H) (bf16x8){L[0], L[1], L[2], L[3], H[0], H[1], H[2], H[3]}
    od = __builtin_amdgcn_mfma_f32_32x32x16_bf16(pa0, ATT_PK(l0, h0), od, 0, 0, 0);
    od = __builtin_amdgcn_mfma_f32_32x32x16_bf16(pa1, ATT_PK(l1, h1), od, 0, 0, 0);
    od = __builtin_amdgcn_mfma_f32_32x32x16_bf16(pa2, ATT_PK(l2, h2), od, 0, 0, 0);
    od = __builtin_amdgcn_mfma_f32_32x32x16_bf16(pa3, ATT_PK(l3, h3), od, 0, 0, 0);
#undef ATT_PK
}
template <int NO> __device__ __forceinline__ void rescale_o(f32x16 (&o)[NO], float alpha, LAS float* al_l, int r32, int hi) {
    if (__any(alpha < 1.f)) { if (hi == 0) al_l[r32] = alpha; asm volatile("s_waitcnt lgkmcnt(0)" ::: "memory");
#pragma unroll
        for (int r = 0; r < 16; ++r) { const float a = al_l[crow(r, hi)];
#pragma unroll
            for (int d = 0; d < NO; ++d) o[d][r] *= a; } }
}
__device__ __forceinline__ void rows_bcast(float v, float (&out)[16], LAS float* li_l, int r32, int hi) {
    if (hi == 0) li_l[r32] = v; asm volatile("s_waitcnt lgkmcnt(0)" ::: "memory");
#pragma unroll
    for (int r = 0; r < 16; ++r) out[r] = li_l[crow(r, hi)];
}
template <int NO> __device__ __forceinline__ void store_rows(LAS unsigned char* stg, const f32x16 (&o)[NO], const float (&rs)[16], const float (&cs)[NO], bf16* Og, size_t ld, int lane) {
    constexpr int RB = 64 * NO;
    const int r32 = lane & 31, hi = lane >> 5;
    LAS unsigned char* wp = stg + hi * 4 * RB + r32 * 2;
#pragma unroll
    for (int d = 0; d < NO; ++d)
#pragma unroll
        for (int r = 0; r < 16; ++r) *(LAS bf16*)(wp + ((r & 3) + 8 * (r >> 2)) * RB + 64 * d) = (bf16)f2bf(o[d][r] * rs[r] * cs[d]);
    asm volatile("s_waitcnt lgkmcnt(0)" ::: "memory");
#pragma unroll
    for (int i = 0; i < 2 * NO; ++i) { const int n = lane + 64 * i, row = n / (4 * NO), c = n % (4 * NO);
        const u32x4 v = *(const LAS u32x4*)(stg + n * 16); *(GAS u32x4*)(Og + (size_t)row * ld + c * 8) = v; }
    asm volatile("s_waitcnt lgkmcnt(0)" ::: "memory");
}
}

struct Frame {
    LAS unsigned char* lds;
    volatile LAS unsigned* MISC;
    gu32* ctl;
    int tid, lane, wave;
    int vcu, G;
    unsigned char* ws;
    float* out;
    decltype(__builtin_amdgcn_kernarg_segment_ptr()) karg;
};
#define CAS __attribute__((address_space(4)))
__device__ __forceinline__ const float* inp(const Frame& F, int i) { return ((const float* const CAS*)(const CAS void*)F.karg)[i]; }
#define WSP(off) ((bf16*)(F.ws + (off)))
#define TABP ((float*)(F.ws + WS_TAB))
#define GW (F.vcu * NWAVES + F.wave)
#define NGW (F.G * NWAVES)
typedef unsigned v2u __attribute__((ext_vector_type(2)));
__device__ __forceinline__ float wave_sum(float v) {
#pragma unroll
    for (int o = 1; o < 64; o <<= 1) v += __shfl_xor(v, o);
    return v;
}
__device__ __forceinline__ float wave_max(float v) {
#pragma unroll
    for (int o = 1; o < 64; o <<= 1) v = fmaxf(v, __shfl_xor(v, o));
    return v;
}
__device__ __forceinline__ float bflo(unsigned w) { return __uint_as_float(w << 16); }
__device__ __forceinline__ float bfhi(unsigned w) { return __uint_as_float(w & 0xffff0000u); }
__device__ __forceinline__ float bf1(bf16 h) { return __uint_as_float(((unsigned)h) << 16); }

__device__ __forceinline__ void p0_transpose_item(const float* W, int K, int N, bf16* WT, int row_off, LAS float* scr, int item, int lane, float sc) {
    const int nblk = N / 32, kb = item / nblk, nb = item % nblk, k0 = 64 * kb, n0 = 32 * nb;
#pragma unroll 8
    for (int i = 0; i < 32; ++i) { const int kk = 2 * i + (lane >> 5); scr[kk * 33 + (lane & 31)] = W[(size_t)(k0 + kk) * N + n0 + (lane & 31)] * sc; }
    LDS_WAIT(); asm volatile("" ::: "memory");
    const int c = lane & 7;
#pragma unroll
    for (int j = 0; j < 4; ++j) { const int n = (lane >> 3) + 8 * j; const LAS float* s = scr + (8 * c) * 33 + n;
        v4u o; o.x = pk2(s[0 * 33], s[1 * 33]); o.y = pk2(s[2 * 33], s[3 * 33]); o.z = pk2(s[4 * 33], s[5 * 33]); o.w = pk2(s[6 * 33], s[7 * 33]);
        *(GAS v4u*)(WT + (size_t)(row_off + n0 + n) * K + k0 + 8 * c) = o; }
    LDS_WAIT(); asm volatile("" ::: "memory");
}
__device__ __forceinline__ void rms_row_bf16(const float* xrow, const float* g, bf16* orow, int lane, float eps) {
    const GAS f32x4* xr = (const GAS f32x4*)xrow + lane; const GAS f32x4* gr = (const GAS f32x4*)g + lane;
    f32x4 v[8]; float s = 0.f;
#pragma unroll
    for (int j = 0; j < 8; ++j) { v[j] = xr[64 * j]; s += (v[j].x * v[j].x + v[j].y * v[j].y) + (v[j].z * v[j].z + v[j].w * v[j].w); }
    const float rs = 1.0f / sqrtf(wave_sum(s) * (1.f / DM) + eps);
    GAS v2u* o8 = (GAS v2u*)orow + lane;
#pragma unroll
    for (int j = 0; j < 8; ++j) { const f32x4 gg = gr[64 * j]; v2u o; o.x = pk2(v[j].x * rs * gg.x, v[j].y * rs * gg.y); o.y = pk2(v[j].z * rs * gg.z, v[j].w * rs * gg.w); o8[64 * j] = o; }
}
__device__ __forceinline__ void rms_row_f32(const float* xrow, const float* g, float* orow, int lane, float eps) {
    const GAS f32x4* xr = (const GAS f32x4*)xrow + lane; const GAS f32x4* gr = (const GAS f32x4*)g + lane;
    f32x4 v[8]; float s = 0.f;
#pragma unroll
    for (int j = 0; j < 8; ++j) { v[j] = xr[64 * j]; s += (v[j].x * v[j].x + v[j].y * v[j].y) + (v[j].z * v[j].z + v[j].w * v[j].w); }
    const float rs = 1.0f / sqrtf(wave_sum(s) * (1.f / DM) + eps);
    GAS f32x4* o = (GAS f32x4*)orow + lane;
#pragma unroll
    for (int j = 0; j < 8; ++j) { const f32x4 gg = gr[64 * j]; o[64 * j] = (f32x4){v[j].x * rs * gg.x, v[j].y * rs * gg.y, v[j].z * rs * gg.z, v[j].w * rs * gg.w}; }
}
__device__ __forceinline__ int t5_bucket(int n) {
    if (n < 16) return n < 0 ? 0 : n;
    int b = 16;
    b += (n >= 19) + (n >= 21) + (n >= 24) + (n >= 27) + (n >= 31) + (n >= 35) + (n >= 40) + (n >= 46) + (n >= 52) + (n >= 59) + (n >= 67) + (n >= 77) + (n >= 87) + (n >= 99) + (n >= 113);
    return b;
}
__device__ __forceinline__ void phase_a(Frame& F, int l, const float* xin) {
    LAS float* scr = (LAS float*)(F.lds + RING_OFF + F.wave * 16384);
    const int gw = GW;
    constexpr int I_IN = (DM / 64) * (DIN / 32), I_MEM = (DM / 64) * (2048 / 32), I_BR = (BW / 64) * (DM / 32), I_OUT = (DM / 64) * (DM / 32), I_1 = (DM / 64) * (DFF / 32), I_2 = (DFF / 64) * (DM / 32);
    constexpr int NITEMS = I_IN + I_MEM + 3 * I_BR + I_OUT + I_1 + I_2;
    const float* w_in = inp(F, 4) + (size_t)l * DM * DIN; const float* w_mem = inp(F, 13) + (size_t)l * DM * 2048; const float* w_br = inp(F, 14) + (size_t)l * 3 * BW * DM;
    const float* w_out = inp(F, 15) + (size_t)l * DM * DM; const float* w_1 = inp(F, 17) + (size_t)l * DM * DFF; const float* w_2 = inp(F, 18) + (size_t)l * DFF * DM;
    for (int it = gw; it < NITEMS; it += NGW) {
        int r = it;
        if (r < I_IN) { const int n0 = 32 * (r % (DIN / 32)); const float sc = (n0 < C_KA) ? QS_A : (n0 >= C_QB && n0 < C_KB) ? QS_A : (n0 >= C_QC && n0 < C_GATE) ? QS_C : 1.0f;
            p0_transpose_item(w_in, DM, DIN, WSP(WS_WIN), 0, scr, r, F.lane, sc); continue; } r -= I_IN;
        if (r < I_MEM) { p0_transpose_item(w_mem, DM, 2048, WSP(WS_WMEM), 0, scr, r, F.lane, 1.0f); continue; } r -= I_MEM;
        if (r < 3 * I_BR) { const int b = r / I_BR; p0_transpose_item(w_br + (size_t)b * BW * DM, BW, DM, WSP(WS_WBR) + (size_t)b * DM * BW, 0, scr, r - b * I_BR, F.lane, 1.0f); continue; } r -= 3 * I_BR;
        if (r < I_OUT) { p0_transpose_item(w_out, DM, DM, WSP(WS_WOUT), 0, scr, r, F.lane, 1.0f); continue; } r -= I_OUT;
        if (r < I_1) { p0_transpose_item(w_1, DM, DFF, WSP(WS_W1), 0, scr, r, F.lane, 1.0f); continue; } r -= I_1;
        p0_transpose_item(w_2, DFF, DM, WSP(WS_W2), 0, scr, r, F.lane, 1.0f);
    }
    for (int m = gw; m < T; m += NGW) rms_row_bf16(xin + (size_t)m * DM, inp(F, 3) + (size_t)l * DM, WSP(WS_H) + (size_t)m * DM, F.lane, RMS_EPS);
    for (int m = gw; m < TM; m += NGW) rms_row_bf16(inp(F, 1) + (size_t)m * DM, inp(F, 12) + (size_t)l * DM, WSP(WS_HM) + (size_t)m * DM, F.lane, RMS_EPS);
    if (blockIdx.x == 0) {
        const float* rb = inp(F, 2);
        if (l == 0) {
            for (int i = F.tid; i < 16 * 128; i += NWAVES * 64) { const int h = i >> 7, d = i & 127; TABP[TAB_A + i] = rb[t5_bucket(d) * 24 + h] * LOG2E; }
            for (int i = F.tid; i < 8 * 128; i += NWAVES * 64) { const int h = i >> 7, d = i & 127; TABP[TAB_B + i] = rb[t5_bucket(d) * 24 + 16 + h] * LOG2E; }
        }
        if (F.wave == 0) {
            const float a = wave_sum(inp(F, 7)[l * 64 + F.lane] * inp(F, 8)[l * 64 + F.lane]), b = wave_sum(inp(F, 9)[l * 64 + F.lane] * inp(F, 10)[l * 64 + F.lane]);
            const float lam_init = 0.8f - 0.6f * expf(-0.3f * (float)l);
            if (F.lane == 0) TABP[TAB_LAM + l] = expf(a) - expf(b) + lam_init;
        }
    }
}

__device__ __forceinline__ void swa_naive_item(Frame& F, int t, int h, float sink2, LAS float* scr) {
    const int lane = F.lane, s = t & (SEQ - 1), hk = h >> 3;
    bf16* zrow = WSP(WS_Z) + (size_t)t * DIN;
    float q[64];
#pragma unroll
    for (int c = 0; c < 8; ++c) { const v4u w = *(const GAS v4u*)(zrow + C_QA + h * 64 + c * 8);
        q[c * 8 + 0] = bflo(w.x); q[c * 8 + 1] = bfhi(w.x); q[c * 8 + 2] = bflo(w.y); q[c * 8 + 3] = bfhi(w.y); q[c * 8 + 4] = bflo(w.z); q[c * 8 + 5] = bfhi(w.z); q[c * 8 + 6] = bflo(w.w); q[c * 8 + 7] = bfhi(w.w); }
    float sc[2];
#pragma unroll
    for (int j = 0; j < 2; ++j) { const int i = lane + 64 * j, kpos = s - 127 + i; const bool valid = kpos >= 0;
        const bf16* krow = WSP(WS_Z) + (size_t)(valid ? t - 127 + i : t) * DIN + C_KA + hk * 64; float d = 0.f;
#pragma unroll
        for (int c = 0; c < 8; ++c) { const v4u w = *(const GAS v4u*)(krow + c * 8);
            d += q[c * 8 + 0] * bflo(w.x) + q[c * 8 + 1] * bfhi(w.x) + q[c * 8 + 2] * bflo(w.y) + q[c * 8 + 3] * bfhi(w.y) + q[c * 8 + 4] * bflo(w.z) + q[c * 8 + 5] * bfhi(w.z) + q[c * 8 + 6] * bflo(w.w) + q[c * 8 + 7] * bfhi(w.w); }
        sc[j] = valid ? d + TABP[TAB_A + h * 128 + (127 - i)] : -INFINITY; }
    const float m = fmaxf(wave_max(fmaxf(sc[0], sc[1])), sink2);
    const float p0 = __builtin_amdgcn_exp2f(sc[0] - m), p1 = __builtin_amdgcn_exp2f(sc[1] - m);
    const float den = wave_sum(p0 + p1) + __builtin_amdgcn_exp2f(sink2 - m);
    scr[lane] = p0; scr[lane + 64] = p1;
    float acc = 0.f;
    const int i0 = (s >= 127) ? 0 : 127 - s;
    for (int i = i0; i < 128; ++i) acc += scr[i] * bf1(WSP(WS_Z)[(size_t)(t - 127 + i) * DIN + C_VA + hk * 64 + lane]);
    zrow[C_QA + h * 64 + lane] = (bf16)f2bf(acc / den);
}
__device__ __forceinline__ void diff_naive_item(Frame& F, int t, int h, float lam, float ln_scale, const float* subg, LAS float* scr) {
    const int lane = F.lane, s = t & (SEQ - 1), tb = t - s;
    bf16* zrow = WSP(WS_Z) + (size_t)t * DIN;
    LAS float* sc1 = scr; LAS float* sc2 = scr + 2048;
    float mx[2];
#pragma unroll
    for (int mp = 0; mp < 2; ++mp) {
        float q[64];
#pragma unroll
        for (int c = 0; c < 8; ++c) { const v4u w = *(const GAS v4u*)(zrow + C_QB + h * 128 + mp * 64 + c * 8);
            q[c * 8 + 0] = bflo(w.x); q[c * 8 + 1] = bfhi(w.x); q[c * 8 + 2] = bflo(w.y); q[c * 8 + 3] = bfhi(w.y); q[c * 8 + 4] = bflo(w.z); q[c * 8 + 5] = bfhi(w.z); q[c * 8 + 6] = bflo(w.w); q[c * 8 + 7] = bfhi(w.w); }
        LAS float* sc = mp ? sc2 : sc1; float m = -INFINITY;
        for (int c0 = 0; c0 <= s; c0 += 64) { const int key = c0 + lane; const bool valid = key <= s;
            const bf16* krow = WSP(WS_Z) + (size_t)(tb + (valid ? key : s)) * DIN + C_KB + h * 128 + mp * 64; float d = 0.f;
#pragma unroll
            for (int c = 0; c < 8; ++c) { const v4u w = *(const GAS v4u*)(krow + c * 8);
                d += q[c * 8 + 0] * bflo(w.x) + q[c * 8 + 1] * bfhi(w.x) + q[c * 8 + 2] * bflo(w.y) + q[c * 8 + 3] * bfhi(w.y) + q[c * 8 + 4] * bflo(w.z) + q[c * 8 + 5] * bfhi(w.z) + q[c * 8 + 6] * bflo(w.w) + q[c * 8 + 7] * bfhi(w.w); }
            const int dist = s - key; const float v = valid ? d + TABP[TAB_B + h * 128 + (dist > 127 ? 127 : dist)] : -INFINITY;
            sc[key] = v; m = fmaxf(m, v); }
        mx[mp] = wave_max(m);
    }
    float l1 = 0.f, l2 = 0.f;
    for (int c0 = 0; c0 <= s; c0 += 64) { const int key = c0 + lane; const float a = __builtin_amdgcn_exp2f(sc1[key] - mx[0]), b = __builtin_amdgcn_exp2f(sc2[key] - mx[1]); sc1[key] = a; sc2[key] = b; l1 += a; l2 += b; }
    l1 = wave_sum(l1); l2 = wave_sum(l2);
    const float r1 = 1.0f / l1, r2 = lam / l2;
    for (int c0 = 0; c0 <= s; c0 += 64) { const int key = c0 + lane; sc1[key] = sc1[key] * r1 - sc2[key] * r2; }
    float a0 = 0.f, a1 = 0.f;
    const bf16* vb = WSP(WS_Z) + (size_t)tb * DIN + C_VB + h * 128 + 2 * lane;
    for (int key = 0; key <= s; ++key) { const unsigned w = *(const GAS unsigned*)(vb + (size_t)key * DIN); const float a = sc1[key]; a0 += a * bflo(w); a1 += a * bfhi(w); }
    const float ss = wave_sum(a0 * a0 + a1 * a1) * (1.0f / 128.0f);
    const float rs = ln_scale / sqrtf(ss + SUBLN_EPS);
    *(GAS unsigned*)(zrow + C_QB + h * 128 + 2 * lane) = pk2(a0 * rs * subg[2 * lane], a1 * rs * subg[2 * lane + 1]);
}
__device__ __forceinline__ void mem_naive_item(Frame& F, int t, int hc, LAS float* scr) {
    const int lane = F.lane, b = t >> 11;
    bf16* zrow = WSP(WS_Z) + (size_t)t * DIN;
    LAS float* qs = scr; LAS float* ps = scr + 256;
    { const v2u w = *(const GAS v2u*)(zrow + C_QC + hc * 256 + 4 * lane); qs[4 * lane + 0] = bflo(w.x); qs[4 * lane + 1] = bfhi(w.x); qs[4 * lane + 2] = bflo(w.y); qs[4 * lane + 3] = bfhi(w.y); }
    float d[4] = {0.f, 0.f, 0.f, 0.f};
    const bf16* kb = WSP(WS_MKV) + (size_t)(b * NMEM + lane) * 2048 + hc * 256;
    for (int c = 0; c < 32; ++c) {
        float q[8];
#pragma unroll
        for (int e = 0; e < 8; ++e) q[e] = qs[c * 8 + e];
#pragma unroll
        for (int j = 0; j < 4; ++j) { const v4u w = *(const GAS v4u*)(kb + (size_t)(64 * j) * 2048 + c * 8);
            d[j] += q[0] * bflo(w.x) + q[1] * bfhi(w.x) + q[2] * bflo(w.y) + q[3] * bfhi(w.y) + q[4] * bflo(w.z) + q[5] * bfhi(w.z) + q[6] * bflo(w.w) + q[7] * bfhi(w.w); }
    }
    const float m = wave_max(fmaxf(fmaxf(d[0], d[1]), fmaxf(d[2], d[3])));
    float sum = 0.f;
#pragma unroll
    for (int j = 0; j < 4; ++j) { const float p = __builtin_amdgcn_exp2f(d[j] - m); ps[lane + 64 * j] = p; sum += p; }
    sum = wave_sum(sum);
    float a0 = 0.f, a1 = 0.f, a2 = 0.f, a3 = 0.f;
    const bf16* vb = WSP(WS_MKV) + (size_t)(b * NMEM) * 2048 + 1024 + hc * 256 + 4 * lane;
    for (int key = 0; key < NMEM; ++key) { const v2u w = *(const GAS v2u*)(vb + (size_t)key * 2048); const float p = ps[key]; a0 += p * bflo(w.x); a1 += p * bfhi(w.x); a2 += p * bflo(w.y); a3 += p * bfhi(w.y); }
    const float r = 1.0f / sum;
    v2u o; o.x = pk2(a0 * r, a1 * r); o.y = pk2(a2 * r, a3 * r);
    *(GAS v2u*)(zrow + C_QC + hc * 256 + 4 * lane) = o;
}


constexpr int SCR_OFF = LDSCTL_OFF + 1024;
constexpr int TBL_OFF = LDSCTL_OFF + 4096;
constexpr int DIFF_STASH = 49152;
static_assert(TBL_OFF + 8 * 224 * 4 <= LDS_BYTES && DIFF_STASH + 65536 <= RING_BYTES, "attention LDS map");

__device__ __forceinline__ void diff_unit(Frame& F, int b, int h, int qb, float lam, float ln_scale, const float* subg) {
    using namespace att;
    int tid_ = F.tid; asm volatile("" : "+v"(tid_));
    const int tid = tid_, lane = tid & 63, wid = __builtin_amdgcn_readfirstlane(tid >> 6), r32 = lane & 31, hi = lane >> 5;
    LAS unsigned char* L = F.lds;
    LAS float* tbl = (LAS float*)(L + TBL_OFF);
    LAS float* al_l = (LAS float*)(L + SCR_OFF + wid * 256); LAS float* li_l = al_l + 32;
    LAS unsigned* stash = (LAS unsigned*)(L + DIFF_STASH) + wid * 2048 + lane;
    { const float* TB = TABP + TAB_B + h * 128;
      if (tid < 208) { const int dist = tid - 94; tbl[tid] = dist < 0 ? -INFINITY : (dist > 112 ? 0.f : TB[dist] - TB[127]); } }
    const int q0 = qb * 256, qw = q0 + 32 * wid;
    const bf16* Zb = WSP(WS_Z) + (size_t)b * SEQ * DIN;
    const int NT = 4 * (qb + 1);
    const int lbase = (int)(unsigned)(size_t)L;
    __syncthreads();
#pragma unroll 1
    for (int mp = 0; mp < 2; ++mp) {
        const bf16* Kg = Zb + C_KB + h * 128 + mp * 64; const bf16* Vg = Zb + C_VB + h * 128;
        bf16x8 qr[4];
        { const bf16* Qw = Zb + (size_t)(qw + r32) * DIN + C_QB + h * 128 + mp * 64 + hi * 8;
#pragma unroll
          for (int d0 = 0; d0 < 4; ++d0) qr[d0] = *(const GAS bf16x8*)(Qw + d0 * 16); }
        float m_reg = -1e30f, l_reg = 0.f; f32x16 o[4];
#pragma unroll
        for (int d = 0; d < 4; ++d) o[d] = f32x16{};
        TileRegs<64> kr; TileRegs<128> vr;
        tile_load<64>(kr, Kg, DIN, tid); tile_load<128>(vr, Vg, DIN, tid);
        tile_write_k<64>(kr, L, tid); tile_write_v<4>(vr, L + 16384, tid);
        __syncthreads();
#pragma unroll 1
        for (int j = 0; j < NT; ++j) {
            const int cur = j & 1;
            if (j + 1 < NT) { tile_load<64>(kr, Kg + (size_t)(j + 1) * 64 * DIN, DIN, tid); tile_load<128>(vr, Vg + (size_t)(j + 1) * 64 * DIN, DIN, tid); }
            if (64 * j <= qw + 31) {
                f32x16 p0, p1; qkt<64>(p0, p1, L + cur * 8192, qr, r32, hi);
                if (64 * j + 63 + 113 > qw) {
                    const int base = qw + r32 - 64 * j + 94;
#pragma unroll
                    for (int r = 0; r < 16; ++r) { const int i0 = base - crow(r, hi), i1 = i0 - 32; p0[r] += tbl[i0 > 207 ? 207 : i0]; p1[r] += tbl[i1 > 207 ? 207 : i1]; }
                }
                float alpha; bf16x8 pa0, pa1, pa2, pa3;
                softmax_tile(p0, p1, m_reg, l_reg, alpha, pa0, pa1, pa2, pa3);
                rescale_o<4>(o, alpha, al_l, r32, hi);
                const int vb = lbase + 16384 + cur * 16384 + v_rd_base(lane);
                pv_one<4, 0>(o[0], vb, pa0, pa1, pa2, pa3); pv_one<4, 1>(o[1], vb, pa0, pa1, pa2, pa3); pv_one<4, 2>(o[2], vb, pa0, pa1, pa2, pa3); pv_one<4, 3>(o[3], vb, pa0, pa1, pa2, pa3);
            }
            if (j + 1 < NT) { tile_write_k<64>(kr, L + (cur ^ 1) * 8192, tid); tile_write_v<4>(vr, L + 16384 + (cur ^ 1) * 16384, tid); }
            __syncthreads();
        }
        float rl[16]; rows_bcast(1.0f / l_reg, rl, li_l, r32, hi);
        if (mp == 0) {
#pragma unroll
            for (int d = 0; d < 4; ++d)
#pragma unroll
                for (int r = 0; r < 16; r += 2) stash[(d * 8 + (r >> 1)) * 64] = cvtpk(o[d][r] * rl[r], o[d][r + 1] * rl[r + 1]);
        } else {
            float ss[16];
#pragma unroll
            for (int r = 0; r < 16; ++r) ss[r] = 0.f;
#pragma unroll
            for (int d = 0; d < 4; ++d)
#pragma unroll
                for (int r = 0; r < 16; r += 2) { const unsigned w = stash[(d * 8 + (r >> 1)) * 64];
                    const float c0 = bflo(w) - lam * (o[d][r] * rl[r]), c1 = bfhi(w) - lam * (o[d][r + 1] * rl[r + 1]);
                    o[d][r] = c0; o[d][r + 1] = c1; ss[r] += c0 * c0; ss[r + 1] += c1 * c1; }
#pragma unroll
            for (int r = 0; r < 16; ++r) {
#pragma unroll
                for (int off = 1; off < 32; off <<= 1) ss[r] += __shfl_xor(ss[r], off);
                ss[r] = ln_scale / sqrtf(ss[r] * (1.0f / 128.0f) + SUBLN_EPS); }
            int lane_e = lane; asm volatile("" : "+v"(lane_e));
            float cs[4];
#pragma unroll
            for (int d = 0; d < 4; ++d) cs[d] = subg[32 * d + (lane_e & 31)];
            store_rows<4>(L + DIFF_STASH + wid * 8192, o, ss, cs, WSP(WS_Z) + (size_t)b * SEQ * DIN + (size_t)qw * DIN + C_QB + h * 128, DIN, lane_e);
        }
    }
}
__device__ __forceinline__ void swa_unit(Frame& F, int b, int hk, int rb, const float* sinks_l) {
    using namespace att;
    int tid_ = F.tid; asm volatile("" : "+v"(tid_));
    const int tid = tid_, lane = tid & 63, wid = __builtin_amdgcn_readfirstlane(tid >> 6), r32 = lane & 31, hi = lane >> 5;
    LAS unsigned char* L = F.lds;
    LAS float* tbl = (LAS float*)(L + TBL_OFF) + wid * 224;
    LAS float* al_l = (LAS float*)(L + SCR_OFF + wid * 256); LAS float* li_l = al_l + 32;
    const int h = hk * 8 + wid;
    { const float* TA = TABP + TAB_A + hk * 8 * 128; LAS float* tb = (LAS float*)(L + TBL_OFF);
      for (int i = tid; i < 8 * 224; i += NWAVES * 64) { const int w = i / 224, dist = (i - w * 224) - 63; tb[i] = (dist < 0 || dist > 127) ? -INFINITY : TA[w * 128 + dist]; } }
    const int s0 = 32 * rb, a = s0 >> 6, j0 = a >= 2 ? a - 2 : 0, NT = a - j0 + 1;
    const bf16* Zb = WSP(WS_Z) + (size_t)b * SEQ * DIN;
    const bf16* Kg = Zb + (size_t)j0 * 64 * DIN + C_KA + hk * 64; const bf16* Vg = Zb + (size_t)j0 * 64 * DIN + C_VA + hk * 64;
    const int lbase = (int)(unsigned)(size_t)L;
    const float sink2 = sinks_l[h] * LOG2E;
    __syncthreads();
    bf16x8 qr[4];
    { const bf16* Qw = Zb + (size_t)(s0 + r32) * DIN + C_QA + h * 64 + hi * 8;
#pragma unroll
      for (int d0 = 0; d0 < 4; ++d0) qr[d0] = *(const GAS bf16x8*)(Qw + d0 * 16); }
    float m_reg = -1e30f, l_reg = 0.f; f32x16 o[2]; o[0] = f32x16{}; o[1] = f32x16{};
    TileRegs<64> kr, vr;
    tile_load<64>(kr, Kg, DIN, tid); tile_load<64>(vr, Vg, DIN, tid);
    tile_write_k<64>(kr, L, tid); tile_write_v<2>(vr, L + 16384, tid);
    __syncthreads();
#pragma unroll 1
    for (int j = 0; j < NT; ++j) {
        const int cur = j & 1;
        if (j + 1 < NT) { tile_load<64>(kr, Kg + (size_t)(j + 1) * 64 * DIN, DIN, tid); tile_load<64>(vr, Vg + (size_t)(j + 1) * 64 * DIN, DIN, tid); }
        {
            f32x16 p0, p1; qkt<64>(p0, p1, L + cur * 8192, qr, r32, hi);
            const int base = s0 + r32 - 64 * (j0 + j) + 63;
#pragma unroll
            for (int r = 0; r < 16; ++r) { const int i0 = base - crow(r, hi), i1 = i0 - 32; p0[r] += tbl[i0 > 222 ? 222 : i0]; p1[r] += tbl[i1 > 222 ? 222 : i1]; }
            float alpha; bf16x8 pa0, pa1, pa2, pa3;
            softmax_tile(p0, p1, m_reg, l_reg, alpha, pa0, pa1, pa2, pa3);
            rescale_o<2>(o, alpha, al_l, r32, hi);
            const int vb = lbase + 16384 + cur * 8192 + v_rd_base(lane);
            pv_one<2, 0>(o[0], vb, pa0, pa1, pa2, pa3); pv_one<2, 1>(o[1], vb, pa0, pa1, pa2, pa3);
        }
        if (j + 1 < NT) { tile_write_k<64>(kr, L + (cur ^ 1) * 8192, tid); tile_write_v<2>(vr, L + 16384 + (cur ^ 1) * 8192, tid); }
        __syncthreads();
    }
    float rl[16]; rows_bcast(1.0f / (l_reg + __builtin_amdgcn_exp2f(sink2 - m_reg)), rl, li_l, r32, hi);
    { int lane_e = lane; asm volatile("" : "+v"(lane_e)); const float cs[2] = {1.f, 1.f};
      store_rows<2>(L + wid * 4096, o, rl, cs, WSP(WS_Z) + (size_t)b * SEQ * DIN + (size_t)s0 * DIN + C_QA + h * 64, DIN, lane_e); }
}
__device__ __forceinline__ void mem_unit(Frame& F, int b, int hc, int qb) {
    using namespace att;
    int tid_ = F.tid; asm volatile("" : "+v"(tid_));
    const int tid = tid_, lane = tid & 63, wid = __builtin_amdgcn_readfirstlane(tid >> 6), r32 = lane & 31, hi = lane >> 5, rw = wid & 3, vh = wid >> 2;
    LAS unsigned char* L = F.lds;
    LAS float* al_l = (LAS float*)(L + SCR_OFF + wid * 256); LAS float* li_l = al_l + 32;
    const int qw = qb * 128 + 32 * rw;
    const bf16* Zb = WSP(WS_Z) + (size_t)b * SEQ * DIN;
    const bf16* Kg = WSP(WS_MKV) + (size_t)b * NMEM * 2048 + hc * 256; const bf16* Vg = Kg + 1024;
    const int lbase = (int)(unsigned)(size_t)L;
    __syncthreads();
    bf16x8 qr[16];
    { const bf16* Qw = Zb + (size_t)(qw + r32) * DIN + C_QC + hc * 256 + hi * 8;
#pragma unroll
      for (int d0 = 0; d0 < 16; ++d0) qr[d0] = *(const GAS bf16x8*)(Qw + d0 * 16); }
    float m_reg = -1e30f, l_reg = 0.f; f32x16 o[4];
#pragma unroll
    for (int d = 0; d < 4; ++d) o[d] = f32x16{};
    TileRegs<256> sr;
    tile_load<256>(sr, Kg, 2048, tid); tile_write_k<256>(sr, L, tid);
    tile_load<256>(sr, Vg, 2048, tid); tile_write_v<8>(sr, L + 65536, tid);
    __syncthreads();
#pragma unroll 1
    for (int j = 0; j < 4; ++j) {
        const int cur = j & 1;
        if (j + 1 < 4) tile_load<256>(sr, Kg + (size_t)(j + 1) * 64 * 2048, 2048, tid);
        f32x16 p0, p1; qkt<256>(p0, p1, L + cur * 32768, qr, r32, hi);
        if (j + 1 < 4) { tile_write_k<256>(sr, L + (cur ^ 1) * 32768, tid); tile_load<256>(sr, Vg + (size_t)(j + 1) * 64 * 2048, 2048, tid); }
        float alpha; bf16x8 pa0, pa1, pa2, pa3;
        softmax_tile(p0, p1, m_reg, l_reg, alpha, pa0, pa1, pa2, pa3);
        rescale_o<4>(o, alpha, al_l, r32, hi);
        const int vb = lbase + 65536 + cur * 32768 + vh * 2048 + v_rd_base(lane);
        pv_one<8, 0>(o[0], vb, pa0, pa1, pa2, pa3); pv_one<8, 1>(o[1], vb, pa0, pa1, pa2, pa3); pv_one<8, 2>(o[2], vb, pa0, pa1, pa2, pa3); pv_one<8, 3>(o[3], vb, pa0, pa1, pa2, pa3);
        if (j + 1 < 4) tile_write_v<8>(sr, L + 65536 + (cur ^ 1) * 32768, tid);
        __syncthreads();
    }
    float rl[16]; rows_bcast(1.0f / l_reg, rl, li_l, r32, hi);
    { int lane_e = lane; asm volatile("" : "+v"(lane_e)); const float cs[4] = {1.f, 1.f, 1.f, 1.f};
      store_rows<4>(L + wid * 8192, o, rl, cs, WSP(WS_Z) + (size_t)b * SEQ * DIN + (size_t)qw * DIN + C_QC + hc * 256 + vh * 128, DIN, lane_e); }
}
struct Args { const float* in[20]; float* out; unsigned char* ws; };
__global__ void __launch_bounds__(NWAVES * 64, 2) mk_fwd(Args args) {
    extern __shared__ __attribute__((aligned(16))) unsigned char lds[];
    Frame F;
    F.lds = (LAS unsigned char*)lds;
    F.MISC = (volatile LAS unsigned*)(F.lds + MISC_OFF);
    F.tid = threadIdx.x; F.lane = F.tid & 63; F.wave = __builtin_amdgcn_readfirstlane(F.tid >> 6);
    F.G = gridDim.x; { const int bx = blockIdx.x; F.vcu = (F.G % 8 == 0) ? (bx % 8) * (F.G / 8) + bx / 8 : bx; }
    F.ws = args.ws; F.out = args.out; F.karg = __builtin_amdgcn_kernarg_segment_ptr();
    F.ctl = (gu32*)(F.ws + WS_CTL);
    for (int u = F.tid; u < (LDS_BYTES - LDSCTL_OFF) / 4; u += NWAVES * 64) ((LAS unsigned*)(F.lds + LDSCTL_OFF))[u] = 0u;
    __syncthreads();
    XcdBarrier bar = xcd_barrier_post((unsigned*)(F.ctl + CW_BAR), F.MISC + 8);
#define GRID_BAR() xcd_barrier(bar)
#define PHASE_BEGIN() do { int t_ = threadIdx.x; asm volatile("" : "+v"(t_)); F.tid = t_; F.lane = t_ & 63; F.wave = __builtin_amdgcn_readfirstlane(t_ >> 6); \
        unsigned char* w_ = args.ws; asm volatile("" : "+s"(w_)); F.ws = w_; float* o_ = args.out; asm volatile("" : "+s"(o_)); F.out = o_; \
        auto k_ = __builtin_amdgcn_kernarg_segment_ptr(); asm volatile("" : "+s"(k_)); F.karg = k_; } while (0)

    for (int l = 0; l < DEPTH; ++l) {
        PHASE_BEGIN();
        phase_a(F, l, (l == 0) ? inp(F, 0) : (const float*)F.out);
        GRID_BAR();
        PHASE_BEGIN();
        {
            pg8::Gemm g{WSP(WS_H), WSP(WS_WIN), DM, DM, DM, 0, 0, 0}; pg8::StaticOrder S; S.init(T, DIN, F.G, (int)blockIdx.x);
            pg8::EpiZ E{WSP(WS_Z), DIN, inp(F, 5) + (size_t)l * 3 * DM, C_GATE / 256};
            pg8::gemm_phase<pg8::EpiZ, pg8::StaticOrder, true, true>(F.lds + RING_OFF, g, S, E, F.tid);
        }
        {
            pg8::Gemm g{WSP(WS_HM), WSP(WS_WMEM), DM, DM, DM, 0, 0, 0}; pg8::StaticOrder S; S.init(TM, 2048, F.G, (int)blockIdx.x);
            pg8::EpiBf16<0> E{WSP(WS_MKV), 2048};
            pg8::gemm_phase<pg8::EpiBf16<0>, pg8::StaticOrder, true, true>(F.lds + RING_OFF, g, S, E, F.tid);
        }
        GRID_BAR();
        PHASE_BEGIN();
        {
            const float* sinks = inp(F, 6) + l * 16;
            const float lam = TABP[TAB_LAM + l]; const float ln_scale = 1.0f - (0.8f - 0.6f * expf(-0.3f * (float)l));
            const float* subg = inp(F, 11) + l * 128;
#if MFMA_DIFF
            for (int u = F.vcu; u < 1024; u += F.G) { const int i = u >> 8, c = u & 255, bh = c >> 1, half = c & 1;
                const int qb = half ? (i == 0 ? 2 : i == 1 ? 5 : i == 2 ? 3 : 4) : (i == 0 ? 0 : i == 1 ? 7 : i == 2 ? 1 : 6);
                diff_unit(F, bh >> 3, bh & 7, qb, lam, ln_scale, subg); }
#endif
#if MFMA_SWA
            for (int u = F.vcu; u < 2048; u += F.G) swa_unit(F, u >> 7, (u >> 6) & 1, u & 63, sinks);
#endif
#if MFMA_MEM
            for (int u = F.vcu; u < 1024; u += F.G) mem_unit(F, u >> 6, (u >> 4) & 3, u & 15);
#endif
#if !MFMA_DIFF || !MFMA_SWA || !MFMA_MEM
            __syncthreads();
            LAS float* scr = (LAS float*)(F.lds + RING_OFF + F.wave * 16384);
            const int gw = GW;
#if !MFMA_SWA
            for (int it = gw; it < T * 16; it += NGW) { const int h = it & 15; swa_naive_item(F, it >> 4, h, sinks[h] * LOG2E, scr); }
#endif
#if !MFMA_DIFF
            for (int it = gw; it < T * 8; it += NGW) diff_naive_item(F, it >> 3, it & 7, lam, ln_scale, subg, scr);
#endif
#if !MFMA_MEM
            for (int it = gw; it < T * 4; it += NGW) mem_naive_item(F, it >> 2, it & 3, scr);
#endif
#endif
        }
        GRID_BAR();
        PHASE_BEGIN();
        {
            pg8::Gemm g{WSP(WS_Z) + C_QA, WSP(WS_WBR), BW, DIN, BW, (long)C_QB * 2, (long)C_QC * 2, (long)DM * BW * 2}; pg8::BranchOrder<3> S; S.init(T, DM, F.G, (int)blockIdx.x);
            pg8::EpiBranch E{WSP(WS_H), DM, WSP(WS_Z) + C_GATE, DIN, DM};
            pg8::gemm_phase<pg8::EpiBranch, pg8::BranchOrder<3>, true, true>(F.lds + RING_OFF, g, S, E, F.tid);
        }
        GRID_BAR();
        PHASE_BEGIN();
        {
            pg8::Gemm g{WSP(WS_H), WSP(WS_WOUT), DM, DM, DM, 0, 0, 0}; pg8::StaticOrder S; S.init(T, DM, F.G, (int)blockIdx.x);
            pg8::EpiRes E{(l == 0) ? inp(F, 0) : (const float*)F.out, F.out, DM};
            pg8::gemm_phase<pg8::EpiRes, pg8::StaticOrder, true, true>(F.lds + RING_OFF, g, S, E, F.tid);
        }
        GRID_BAR();
        PHASE_BEGIN();
        for (int m = GW; m < T; m += NGW) rms_row_bf16(F.out + (size_t)m * DM, inp(F, 16) + (size_t)l * DM, WSP(WS_H) + (size_t)m * DM, F.lane, RMS_EPS);
        GRID_BAR();
        PHASE_BEGIN();
        {
            pg8::Gemm g{WSP(WS_H), WSP(WS_W1), DM, DM, DM, 0, 0, 0}; pg8::StaticOrder S; S.init(T, DFF, F.G, (int)blockIdx.x);
            pg8::EpiBf16<1> E{WSP(WS_Z), DFF};
            pg8::gemm_phase<pg8::EpiBf16<1>, pg8::StaticOrder, true, true>(F.lds + RING_OFF, g, S, E, F.tid);
        }
        GRID_BAR();
        PHASE_BEGIN();
        {
            pg8::Gemm g{WSP(WS_Z), WSP(WS_W2), DFF, DFF, DFF, 0, 0, 0}; pg8::StaticOrder S; S.init(T, DM, F.G, (int)blockIdx.x);
            pg8::EpiRes E{F.out, F.out, DM};
            pg8::gemm_phase<pg8::EpiRes, pg8::StaticOrder, true, true>(F.lds + RING_OFF, g, S, E, F.tid);
        }
        GRID_BAR();
    }
    PHASE_BEGIN();
    for (int m = GW; m < T; m += NGW) rms_row_f32(F.out + (size_t)m * DM, inp(F, 19), F.out + (size_t)m * DM, F.lane, RMS_EPS);
}

extern "C" void kernel_launch(void* const* d_in, const int* in_sizes, int n_in, void* d_out, int out_size, void* d_ws, size_t ws_size, hipStream_t stream) {
    static int grid = 0;
    if (grid == 0) {
        if (n_in != 20 || in_sizes[0] != T * DM || out_size != T * DM || ws_size < WS_END) { fprintf(stderr, "kernel_launch: unexpected shapes (n_in %d, in0 %d, out %d, ws %zu); nothing launched\n", n_in, n_in > 0 ? in_sizes[0] : -1, out_size, ws_size); grid = -1; return; }
        int dev = 0, cus = 0, per_cu = 0;
        if (hipGetDevice(&dev) != hipSuccess || hipDeviceGetAttribute(&cus, hipDeviceAttributeMultiprocessorCount, dev) != hipSuccess) { grid = -1; return; }
        if (hipFuncSetAttribute((const void*)mk_fwd, hipFuncAttributeMaxDynamicSharedMemorySize, LDS_BYTES) != hipSuccess) { fprintf(stderr, "kernel_launch: hipFuncSetAttribute failed\n"); grid = -1; return; }
        if (hipOccupancyMaxActiveBlocksPerMultiprocessor(&per_cu, (const void*)mk_fwd, NWAVES * 64, LDS_BYTES) != hipSuccess || per_cu < 1) fprintf(stderr, "kernel_launch: occupancy query reports %d\n", per_cu);
        (void)hipGetLastError();
        grid = cus;
    }
    if (grid < 0) return;
    if (hipMemsetAsync((char*)d_ws + WS_CTL, 0, CTL_ZERO_BYTES, stream) != hipSuccess) return;
    Args a{};
    for (int i = 0; i < 20; ++i) a.in[i] = (const float*)d_in[i];
    a.out = (float*)d_out; a.ws = (unsigned char*)d_ws;
    hipLaunchKernelGGL(mk_fwd, dim3(grid), dim3(NWAVES * 64), LDS_BYTES, stream, a);
    const hipError_t le = hipPeekAtLastError();
    if (le != hipSuccess) fprintf(stderr, "kernel_launch: launch failed: %s\n", hipGetErrorName(le));
}
```

```cpp
#include <hip/hip_runtime.h>
#include <cstdio>
#include <cstdint>
#ifndef REP_PA
#define REP_PA 1
#endif
#ifndef REP_PB
#define REP_PB 1
#endif
#ifndef REP_PC
#define REP_PC 1
#endif
#ifndef REP_PD
#define REP_PD 1
#endif
#ifndef REP_PE
#define REP_PE 1
#endif
#ifndef REP_PF
#define REP_PF 1
#endif
#ifndef REP_PG
#define REP_PG 1
#endif
#ifndef REP_PH
#define REP_PH 1
#endif
#ifndef PROBE_EPI2_Z
#define PROBE_EPI2_Z false
#endif
#ifndef PROBE_EPI2_U
#define PROBE_EPI2_U false
#endif
#ifndef EPI_NT
#define EPI_NT 1
#endif
#if EPI_NT
#define EPI_STREAM_STORE(p, v) __builtin_nontemporal_store((v), (p))
#else
#define EPI_STREAM_STORE(p, v) (*(p) = (v))
#endif
#ifndef PH_A_AUX
#define PH_A_AUX 0
#endif
#ifndef ATT_STATIC_PRIO
#define ATT_STATIC_PRIO 0
#endif
#ifndef GEMM_WGM
#define GEMM_WGM 4
#endif
#ifndef PH_WGM
#define PH_WGM 4
#endif
#ifndef PB_F8_WGM
#define PB_F8_WGM 8
#endif
#ifndef PB_BF_WGM
#define PB_BF_WGM 8
#endif
#ifndef PD_STAGGER_SHIFT
#define PD_STAGGER_SHIFT 0
#endif
#ifndef PD_STAGGER_TICKS
#define PD_STAGGER_TICKS 0
#endif
#ifndef PROBE_QOB
#define PROBE_QOB 0
#endif
#ifndef PROBE_QOA
#define PROBE_QOA 0
#endif
#ifndef PROBE_QOC
#define PROBE_QOC 0
#endif
#ifndef XVAR_DIFF
#define XVAR_DIFF 0
#endif
#ifndef XREP_DIFF
#define XREP_DIFF 0
#endif
#ifndef XREP_SWA
#define XREP_SWA 0
#endif
#ifndef XREP_MEM
#define XREP_MEM 0
#endif
#ifndef MFMA_DIFF
#define MFMA_DIFF 1
#endif
#ifndef MFMA_SWA
#define MFMA_SWA 1
#endif
#ifndef MFMA_MEM
#define MFMA_MEM 1
#endif

namespace pg8 {
#define PG8_LAS __attribute__((address_space(3)))
typedef unsigned short bf16_t;
typedef short bf16x8 __attribute__((ext_vector_type(8)));
typedef float f32x4 __attribute__((ext_vector_type(4)));
typedef unsigned u32x4 __attribute__((ext_vector_type(4)));
constexpr int BM = 256, BK = 64, HALF = 128, HTB = HALF * BK * 2  , STAGE_BYTES = 8 * HTB, NXCD = 8, WGM = 8;

__host__ __device__ __forceinline__ int lds_byte(int r, int c) { const int st = (r >> 4) * 2 + (c >> 5), rr = r & 15, cc = c & 31, ob = rr * 64 + cc * 2; return st * 1024 + (ob ^ (((ob >> 9) & 1) << 5)); }
__host__ __device__ __forceinline__ void stage_rc(int b, int& R, int& C) { const int st = b / 1024, sb = b % 1024, swz = sb ^ (((sb >> 9) & 1) << 5); R = (st >> 1) * 16 + swz / 64; C = (st & 1) * 32 + (swz % 64) / 2; }
__host__ __device__ __forceinline__ int perm32(int rho) { const int n = rho >> 4, i = rho & 15; return 8 * (i >> 2) + 4 * n + (i & 3); }

struct Unit { int pm, pn, br; };
struct Gemm { const bf16_t* A; const bf16_t* Bt; int K, lda, ldb; long a_br1, a_br2, b_br; long kstepA, tstepA; int pmul;
    __device__ __forceinline__ long aoff(int br) const { return br == 0 ? 0l : (br == 1 ? a_br1 : a_br2); } };

struct StaticOrder {
    int nM, nN, nwg, G, c, wgm;
    __host__ __device__ void init(int M, int N, int G_, int c_, int wgm_ = WGM) { nM = M / BM; nN = N / BM; nwg = nM * nN; G = G_; c = c_; wgm = wgm_; }
    __host__ __device__ bool tile(long L, Unit& u) const {
        if (L >= nwg) return false;
        int wgid = (int)L; { const int q = nwg / NXCD, r = nwg % NXCD, xcd = wgid % NXCD, off = wgid / NXCD; wgid = (xcd < r ? xcd * (q + 1) : r * (q + 1) + (xcd - r) * q) + off; }
        const int nig = wgm * nN, gid = wgid / nig, fm = gid * wgm, gsz = (nM - fm) < wgm ? (nM - fm) : wgm;
        u.pm = fm + ((wgid % nig) % gsz); u.pn = (wgid % nig) / gsz; u.br = 0; return true;
    }
    __host__ __device__ bool next(int i, Unit& u) const { return tile((long)i * G + c, u); }
    __device__ __forceinline__ void a_ready(const Unit&) const {}
    __device__ __forceinline__ void done(const Unit&) const {}
};
struct TwoGemmOrder : StaticOrder {
    int nM2, nwg2;
    __host__ __device__ void init2(int M2, int N2) { nM2 = M2 / BM; nwg2 = nM2 * (N2 / BM); }
    __host__ __device__ bool next(int i, Unit& u) const { const long L = (long)i * G + c; if (L < nwg) return tile(L, u); const int t = (int)(L - nwg); if (t >= nwg2) return false; u.pm = t % nM2; u.pn = t / nM2; u.br = 1; return true; }
};
template <int NBR> struct BranchOrder : StaticOrder {
    __host__ __device__ bool next(int i, Unit& u) const { const int t = i / NBR; if (!tile((long)t * G + c, u)) return false; u.br = i - t * NBR; return true; }
};

__device__ __forceinline__ unsigned cvt_pk_bf16(float lo, float hi) { unsigned r; asm volatile("v_cvt_pk_bf16_f32 %0, %1, %2" : "=v"(r) : "v"(lo), "v"(hi)); return r; }
__device__ __forceinline__ float bf_lo(unsigned w) { return __uint_as_float(w << 16); }
__device__ __forceinline__ float bf_hi(unsigned w) { return __uint_as_float(w & 0xffff0000u); }


struct EpiZ {
    static constexpr bool PERM = true, AFTER_DRAIN = false, PROBE2 = PROBE_EPI2_Z;
    int pn_split, pn_jump, pn_qa; float ascale3;
    bf16_t* O; int ldc; const float* bgate; int gate_pn0; bf16_t* O2; int ldc2; float ascale; const float* rs; float ascale2;
    __device__ __forceinline__ void operator()(const f32x4 (&acc)[2][2][4][2], const Unit& u, int wr, int wc, int fr_in, int fq_in) const {
        int fr = fr_in, fq = fq_in; asm volatile("" : "+v"(fr), "+v"(fq));
        const int row0 = u.pm * BM + wr * 64 + fr; const int col0 = (u.pn + ((u.pn >= pn_split && u.br == 0) ? pn_jump : 0)) * BM + wc * 32 + 8 * fq;
        const bool gate = u.pn >= gate_pn0 && u.br == 0;
        float a1_ = ascale, a2_ = ascale2, a3_ = ascale3; asm volatile("" : "+s"(a1_), "+s"(a2_), "+s"(a3_));
        const float asc = gate ? a1_ : ((u.pn < pn_qa && u.br == 0) ? a3_ : ((u.pn >= pn_split && u.br == 0) ? a2_ : a1_));
        const __attribute__((address_space(1))) float* bg = (const __attribute__((address_space(1))) float*)bgate; asm volatile("" : "+s"(bg));
        const int bcol = (gate ? (u.pn - gate_pn0) * BM : 0) + wc * 32 + 8 * fq; const float gsel = gate ? 1.f : 0.f;
        const __attribute__((address_space(1))) float* rsp = (const __attribute__((address_space(1))) float*)rs; asm volatile("" : "+s"(rsp));
        float rsr[2][4]; const float rsel = u.br ? 0.f : 1.f;
#pragma unroll
        for (int ai = 0; ai < 2; ++ai)
#pragma unroll
            for (int m = 0; m < 4; ++m) { const float r = rsp[row0 + ai * HALF + m * 16]; rsr[ai][m] = ((r - 1.0f) * rsel + 1.0f) * asc; }
        f32x4 bv[2][2];
#pragma unroll
        for (int bj = 0; bj < 2; ++bj)
#pragma unroll
            for (int n = 0; n < 2; ++n) bv[bj][n] = *(const __attribute__((address_space(1))) f32x4*)(bg + bcol + bj * HALF + 4 * n) * gsel;
#pragma unroll
        for (int ai = 0; ai < 2; ++ai)
#pragma unroll
            for (int m = 0; m < 4; ++m) { bf16_t* rowp = (u.br ? O2 : O) + (size_t)(row0 + ai * HALF + m * 16) * (u.br ? ldc2 : ldc) + col0;
#pragma unroll
                for (int bj = 0; bj < 2; ++bj) { f32x4 v0 = acc[ai][bj][m][0] * rsr[ai][m] + bv[bj][0], v1 = acc[ai][bj][m][1] * rsr[ai][m] + bv[bj][1];
#if defined(PROBE_QQKV)
                    if (!gate && u.br == 0) {
#pragma unroll
                        for (int j = 0; j < 4; ++j) { v0[j] = __uint_as_float((__float_as_uint(v0[j]) + (0x00400000u >> PROBE_QQKV)) & ~((0x00800000u >> PROBE_QQKV) - 1u)); v1[j] = __uint_as_float((__float_as_uint(v1[j]) + (0x00400000u >> PROBE_QQKV)) & ~((0x00800000u >> PROBE_QQKV) - 1u)); } }
#endif
                    if (gate) {
#if defined(PROBE_QGATE)
#pragma unroll
                        for (int j = 0; j < 4; ++j) { v0[j] = __uint_as_float((__float_as_uint(v0[j]) + (0x00400000u >> PROBE_QGATE)) & ~((0x00800000u >> PROBE_QGATE) - 1u)); v1[j] = __uint_as_float((__float_as_uint(v1[j]) + (0x00400000u >> PROBE_QGATE)) & ~((0x00800000u >> PROBE_QGATE) - 1u)); }
#endif
#pragma unroll
                        for (int j = 0; j < 4; ++j) { v0[j] = __builtin_amdgcn_rcpf(1.0f + __builtin_amdgcn_exp2f(-1.4426950408889634f * v0[j])); v1[j] = __builtin_amdgcn_rcpf(1.0f + __builtin_amdgcn_exp2f(-1.4426950408889634f * v1[j])); }
                    }
                    u32x4 w; w.x = cvt_pk_bf16(v0[0], v0[1]); w.y = cvt_pk_bf16(v0[2], v0[3]); w.z = cvt_pk_bf16(v1[0], v1[1]); w.w = cvt_pk_bf16(v1[2], v1[3]);
                    EPI_STREAM_STORE((u32x4*)(rowp + bj * HALF), w); } }
    }
};
template <int ACT> struct EpiBf16 {
    static constexpr bool PERM = true, AFTER_DRAIN = false, PROBE2 = false;
    bf16_t* O; int ldc;
    __device__ __forceinline__ void operator()(const f32x4 (&acc)[2][2][4][2], const Unit& u, int wr, int wc, int fr_in, int fq_in) const {
        int fr = fr_in, fq = fq_in; asm volatile("" : "+v"(fr), "+v"(fq));
        const int row0 = u.pm * BM + wr * 64 + fr; const int col0 = u.pn * BM + wc * 32 + 8 * fq;
#pragma unroll
        for (int ai = 0; ai < 2; ++ai)
#pragma unroll
            for (int m = 0; m < 4; ++m) { bf16_t* rowp = O + (size_t)(row0 + ai * HALF + m * 16) * ldc + col0;
#pragma unroll
                for (int bj = 0; bj < 2; ++bj) { f32x4 v0 = acc[ai][bj][m][0], v1 = acc[ai][bj][m][1];
                    if (ACT == 1) {
#pragma unroll
                        for (int j = 0; j < 4; ++j) { const float a = fmaxf(v0[j], 0.f), b = fmaxf(v1[j], 0.f); v0[j] = a * a; v1[j] = b * b; } }
                    u32x4 w; w.x = cvt_pk_bf16(v0[0], v0[1]); w.y = cvt_pk_bf16(v0[2], v0[3]); w.z = cvt_pk_bf16(v1[0], v1[1]); w.w = cvt_pk_bf16(v1[2], v1[3]);
                    *(u32x4*)(rowp + bj * HALF) = w; } }
    }
};
struct EpiUTiled {
    static constexpr bool PERM = true, AFTER_DRAIN = false, PROBE2 = PROBE_EPI2_U;
    bf16_t* O; int nkt;
    __device__ __forceinline__ void operator()(const f32x4 (&acc)[2][2][4][2], const Unit& u, int wr, int wc, int fr_in, int fq_in) const {
        int fr = fr_in, fq = fq_in; asm volatile("" : "+v"(fr), "+v"(fq));
        const int r0 = wr * 64 + fr;
#pragma unroll
        for (int ai = 0; ai < 2; ++ai)
#pragma unroll
            for (int m = 0; m < 4; ++m) { const int r = r0 + ai * HALF + m * 16;
#pragma unroll
                for (int bj = 0; bj < 2; ++bj) { f32x4 v0 = acc[ai][bj][m][0], v1 = acc[ai][bj][m][1];
#pragma unroll
                    for (int j = 0; j < 4; ++j) { const float a = fmaxf(v0[j], 0.f), b = fmaxf(v1[j], 0.f); v0[j] = a * a; v1[j] = b * b; }
                    u32x4 w; w.x = cvt_pk_bf16(v0[0], v0[1]); w.y = cvt_pk_bf16(v0[2], v0[3]); w.z = cvt_pk_bf16(v1[0], v1[1]); w.w = cvt_pk_bf16(v1[2], v1[3]);
                    const int kt = u.pn * 4 + bj * 2 + (wc >> 1), c = (wc & 1) * 32 + 8 * fq;
                    EPI_STREAM_STORE((u32x4*)(O + (((size_t)u.pm * nkt + kt) * 256 + r) * 64 + c), w); } }
    }
};
struct EpiBranch {
    static constexpr bool PERM = true, AFTER_DRAIN = false, PROBE2 = false;
    bf16_t* mrg; int ldm; const bf16_t* gates; int ldg; int gate_br; int gidx0, gstep, first0; float ascale;
    __device__ __forceinline__ void operator()(const f32x4 (&acc)[2][2][4][2], const Unit& u, int wr, int wc, int fr_in, int fq_in) const {
        int fr = fr_in, fq = fq_in; asm volatile("" : "+v"(fr), "+v"(fq));
        const int row0 = u.pm * BM + wr * 64 + fr; const int col0 = u.pn * BM + wc * 32 + 8 * fq;
        const int brx = gidx0 + u.br * gstep; const bool first = (first0 != 0) && (u.br == 0);
#pragma unroll
        for (int ai = 0; ai < 2; ++ai) {
            u32x4 g[4][2], p[4][2];
#pragma unroll
            for (int m = 0; m < 4; ++m) { const size_t row = (size_t)(row0 + ai * HALF + m * 16);
                const bf16_t* gp = gates + row * ldg + (size_t)brx * gate_br + col0; const bf16_t* mp = mrg + row * ldm + col0;
#pragma unroll
                for (int bj = 0; bj < 2; ++bj) { g[m][bj] = *(const u32x4*)(gp + bj * HALF); p[m][bj] = (u32x4){0u, 0u, 0u, 0u}; if (!first) p[m][bj] = *(const u32x4*)(mp + bj * HALF); } }
            asm volatile("" ::: "memory");
#pragma unroll
            for (int m = 0; m < 4; ++m) { bf16_t* mp = mrg + (size_t)(row0 + ai * HALF + m * 16) * ldm + col0;
#pragma unroll
                for (int bj = 0; bj < 2; ++bj) { const u32x4 gg = g[m][bj], pp = p[m][bj]; const f32x4 a0 = acc[ai][bj][m][0] * ascale, a1 = acc[ai][bj][m][1] * ascale;
                    u32x4 w;
                    w.x = cvt_pk_bf16(bf_lo(pp.x) + bf_lo(gg.x) * a0[0], bf_hi(pp.x) + bf_hi(gg.x) * a0[1]);
                    w.y = cvt_pk_bf16(bf_lo(pp.y) + bf_lo(gg.y) * a0[2], bf_hi(pp.y) + bf_hi(gg.y) * a0[3]);
                    w.z = cvt_pk_bf16(bf_lo(pp.z) + bf_lo(gg.z) * a1[0], bf_hi(pp.z) + bf_hi(gg.z) * a1[1]);
                    w.w = cvt_pk_bf16(bf_lo(pp.w) + bf_lo(gg.w) * a1[2], bf_hi(pp.w) + bf_hi(gg.w) * a1[3]);
                    *(u32x4*)(mp + bj * HALF) = w; } }
            asm volatile("" ::: "memory");
        }
    }
};
template <bool W8, bool RS> struct EpiResB {
    static constexpr bool PERM = true, AFTER_DRAIN = false, PROBE2 = false;
    bf16_t* x; int ldx; float* ss; unsigned char* x8; int ld8; const float* rs;
    __device__ __forceinline__ void operator()(const f32x4 (&acc)[2][2][4][2], const Unit& u, int wr, int wc, int fr_in, int fq_in) const {
        int fr = fr_in, fq = fq_in; asm volatile("" : "+v"(fr), "+v"(fq));
        const int row0 = u.pm * BM + wr * 64 + fr, col0 = u.pn * BM + wc * 32 + 8 * fq;
#pragma unroll
        for (int ai = 0; ai < 2; ++ai) {
            u32x4 p[4][2];
            float rq[4];
#pragma unroll
            for (int m = 0; m < 4; ++m) { rq[m] = 1.0f; if constexpr (RS) { const float r_ = rs[row0 + ai * HALF + m * 16]; rq[m] = r_ * r_; } }
#pragma unroll
            for (int m = 0; m < 4; ++m) { const bf16_t* xp = x + (size_t)(row0 + ai * HALF + m * 16) * ldx + col0;
#pragma unroll
                for (int bj = 0; bj < 2; ++bj) p[m][bj] = *(const u32x4*)(xp + bj * HALF); }
            asm volatile("" ::: "memory");
#pragma unroll
            for (int m = 0; m < 4; ++m) { const int row = row0 + ai * HALF + m * 16; bf16_t* xp = x + (size_t)row * ldx + col0; float s = 0.f;
#pragma unroll
                for (int bj = 0; bj < 2; ++bj) { const u32x4 pp = p[m][bj];
                    f32x4 a0 = acc[ai][bj][m][0], a1 = acc[ai][bj][m][1]; if constexpr (RS) { a0 = a0 * rq[m]; a1 = a1 * rq[m]; }
                    const float v0 = bf_lo(pp.x) + a0[0], v1 = bf_hi(pp.x) + a0[1], v2 = bf_lo(pp.y) + a0[2], v3 = bf_hi(pp.y) + a0[3], v4 = bf_lo(pp.z) + a1[0], v5 = bf_hi(pp.z) + a1[1], v6 = bf_lo(pp.w) + a1[2], v7 = bf_hi(pp.w) + a1[3];
                    s += ((v0 * v0 + v1 * v1) + (v2 * v2 + v3 * v3)) + ((v4 * v4 + v5 * v5) + (v6 * v6 + v7 * v7));
                    u32x4 w; w.x = cvt_pk_bf16(v0, v1); w.y = cvt_pk_bf16(v2, v3); w.z = cvt_pk_bf16(v4, v5); w.w = cvt_pk_bf16(v6, v7);
                    *(u32x4*)(xp + bj * HALF) = w;
                    if constexpr (W8) { typedef unsigned u32x2_ __attribute__((ext_vector_type(2))); u32x2_ q; int t0 = 0, t1 = 0;
                        t0 = __builtin_amdgcn_cvt_pk_fp8_f32(v0, v1, t0, false); t0 = __builtin_amdgcn_cvt_pk_fp8_f32(v2, v3, t0, true); t1 = __builtin_amdgcn_cvt_pk_fp8_f32(v4, v5, t1, false); t1 = __builtin_amdgcn_cvt_pk_fp8_f32(v6, v7, t1, true);
                        q.x = (unsigned)t0; q.y = (unsigned)t1; *(u32x2_*)(x8 + (size_t)row * ld8 + col0 + bj * HALF) = q; } }
                s += __shfl_xor(s, 16); s += __shfl_xor(s, 32);
                if (fq == 0) ss[(size_t)row * 32 + u.pn * 4 + wc] = s; }
            asm volatile("" ::: "memory");
        }
    }
};
struct EpiRes {
    static constexpr bool PERM = false, AFTER_DRAIN = false, PROBE2 = false;
    const float* xin; float* xout; int ldc;
    __device__ __forceinline__ void operator()(const f32x4 (&acc)[2][2][4][2], const Unit& u, int wr, int wc, int fr_in, int fq_in) const {
        int fr = fr_in, fq = fq_in; asm volatile("" : "+v"(fr), "+v"(fq));
        const int row0 = u.pm * BM + wr * 64 + fr, col0 = u.pn * BM + wc * 32 + 4 * fq;
#pragma unroll
        for (int ai = 0; ai < 2; ++ai)
#pragma unroll
            for (int m = 0; m < 4; ++m) { const size_t off = (size_t)(row0 + ai * HALF + m * 16) * ldc + col0;
#pragma unroll
                for (int bj = 0; bj < 2; ++bj)
#pragma unroll
                    for (int n = 0; n < 2; ++n) { const f32x4 b = *(const f32x4*)(xin + off + bj * HALF + n * 16); *(f32x4*)(xout + off + bj * HALF + n * 16) = b + acc[ai][bj][m][n]; } }
    }
};
#if defined(PROBE_TRACE)
__device__ volatile unsigned long long g_tu[512]; __device__ volatile int g_tn;
#define PG8_TRACE_UNIT() do { if (blockIdx.x == 0 && threadIdx.x == 0) { const int n_ = g_tn; g_tu[n_ & 511] = __builtin_amdgcn_s_memrealtime(); g_tn = n_ + 1; } } while (0)
#else
#define PG8_TRACE_UNIT() do { } while (0)
#endif
typedef int pg8_v8i __attribute__((ext_vector_type(8))); typedef int pg8_v4i __attribute__((ext_vector_type(4)));
__device__ __forceinline__ pg8_v8i pg8_cat(bf16x8 lo, bf16x8 hi) { const pg8_v4i a = __builtin_bit_cast(pg8_v4i, lo), b = __builtin_bit_cast(pg8_v4i, hi); return (pg8_v8i){a.x, a.y, a.z, a.w, b.x, b.y, b.z, b.w}; }
template <class Epi, class Sched, bool ALIGN_EPI = false, bool SP2 = false, bool F8 = false, int A_AUX = 0>
__device__ __forceinline__ void gemm_phase(PG8_LAS unsigned char* lds, const Gemm g, const Sched& S, const Epi& E, const int tid) {
    const int wid = __builtin_amdgcn_readfirstlane(tid >> 6), lane = tid & 63, wr = wid >> 2, wc = wid & 3, fr = lane & 15, fq = lane >> 4;
    const int K = g.K, nt = K / BK;
    unsigned voffA[2], voffB[2];
#pragma unroll
    for (int i = 0; i < 2; ++i) { int R, C; stage_rc(tid * 16 + i * 8192, R, C); const int Rb = Epi::PERM ? ((R & ~31) + perm32(R & 31)) : R;
        voffA[i] = (unsigned)(R * g.lda + C) * 2u; voffB[i] = (unsigned)(Rb * g.ldb + C) * 2u; }
    const size_t kstep = (size_t)(BK * 2);
    const size_t kstepA = g.kstepA ? (size_t)g.kstepA : kstep;
    const size_t hstepA = (size_t)HALF * g.lda * 2, hstepB = (size_t)HALF * g.ldb * 2;
    const size_t tstepA = g.tstepA ? (size_t)g.tstepA : 2 * hstepA, tstepB = 2 * hstepB;
    const unsigned ldsw = (unsigned)wid * 1024u;
    const int aoff = lds_byte(wr * 64 + fr, fq * 8), boff = lds_byte(wc * 32 + fr, fq * 8);
#define PG8_SA(b, h) (((b) * 2 + (h)) * HTB)
#define PG8_SB(b, h) ((4 + (b) * 2 + (h)) * HTB)
#define PG8_STAGE(bufoff, gbase, voff) do { _Pragma("unroll") for (int _i = 0; _i < 2; ++_i) \
        __builtin_amdgcn_global_load_lds((const unsigned*)((const char*)(gbase) + (voff)[_i]), (PG8_LAS unsigned*)(lds + (bufoff) + ldsw + _i * 8192), 16, 0, ((bufoff) < 4 * HTB ? A_AUX : 0)); } while (0)
#define PG8_LDA(dst, b, h) do { _Pragma("unroll") for (int m = 0; m < 4; ++m) _Pragma("unroll") for (int k = 0; k < 2; ++k) dst[m][k] = *(const PG8_LAS bf16x8*)(lds + PG8_SA(b, h) + aoff + m * 2048 + k * 1024); } while (0)
#define PG8_LDB(dst, b, h) do { _Pragma("unroll") for (int n = 0; n < 2; ++n) _Pragma("unroll") for (int k = 0; k < 2; ++k) dst[n][k] = *(const PG8_LAS bf16x8*)(lds + PG8_SB(b, h) + boff + n * 2048 + k * 1024); } while (0)
#define PG8_MMA(ai, bj, At, Bt) do { __builtin_amdgcn_s_setprio(1); _Pragma("unroll") for (int m = 0; m < 4; ++m) _Pragma("unroll") for (int n = 0; n < 2; ++n) { \
        if constexpr (F8) { const pg8_v8i b8_ = pg8_cat(Bt[n][0], Bt[n][1]), a8_ = pg8_cat(At[m][0], At[m][1]); asm volatile("v_mfma_f32_16x16x128_f8f6f4 %0, %1, %2, %0" : "+v"(acc[ai][bj][m][n]) : "v"(b8_), "v"(a8_)); } \
        else { _Pragma("unroll") for (int k = 0; k < 2; ++k) acc[ai][bj][m][n] = __builtin_amdgcn_mfma_f32_16x16x32_bf16(Bt[n][k], At[m][k], acc[ai][bj][m][n], 0, 0, 0); } } __builtin_amdgcn_s_setprio(0); } while (0)
#define PG8_WAIT_V(n) asm volatile("s_waitcnt vmcnt(" #n ")" ::: "memory")
#define PG8_WAIT_L(n) asm volatile("s_waitcnt lgkmcnt(" #n ")" ::: "memory")
#define PG8_BAR __builtin_amdgcn_s_barrier()
#define PG8_SCHED __builtin_amdgcn_sched_barrier(0)
    __builtin_amdgcn_s_waitcnt(0);
    Unit cur, nxt; int ui = 0;
    if (!S.next(0, cur)) return;
    f32x4 acc[2][2][4][2];
#pragma unroll
    for (int a = 0; a < 2; ++a)
#pragma unroll
        for (int b = 0; b < 2; ++b)
#pragma unroll
            for (int m = 0; m < 4; ++m)
#pragma unroll
                for (int n = 0; n < 2; ++n) acc[a][b][m][n] = (f32x4){0.f, 0.f, 0.f, 0.f};
    bf16x8 At[4][2], B0[2][2], B1[2][2];
    const char* cA = (const char*)g.A + (size_t)(cur.pm * g.pmul) * tstepA + g.aoff(cur.br); const char* cB = (const char*)g.Bt + (size_t)(cur.pn * g.pmul) * tstepB + (long)cur.br * g.b_br;
    S.a_ready(cur);
    if constexpr (SP2) {
        PG8_STAGE(PG8_SB(0, 0), cB, voffB); PG8_STAGE(PG8_SB(0, 1), cB + hstepB, voffB); PG8_STAGE(PG8_SA(0, 0), cA, voffA); PG8_STAGE(PG8_SA(0, 1), cA + hstepA, voffA);
        if (wr == 1) PG8_BAR;
        PG8_WAIT_V(2); PG8_BAR;
        PG8_STAGE(PG8_SB(1, 0), cB + kstep, voffB); PG8_STAGE(PG8_SA(1, 0), cA + kstepA, voffA); PG8_STAGE(PG8_SB(1, 1), cB + hstepB + kstep, voffB);
        PG8_WAIT_V(6); PG8_BAR;
    } else {
        PG8_STAGE(PG8_SB(0, 0), cB, voffB); PG8_STAGE(PG8_SA(0, 0), cA, voffA); PG8_STAGE(PG8_SB(0, 1), cB + hstepB, voffB); PG8_STAGE(PG8_SA(0, 1), cA + hstepA, voffA);
        if (wr == 1) PG8_BAR;
        PG8_WAIT_V(4); PG8_BAR;
        PG8_STAGE(PG8_SB(1, 0), cB + kstep, voffB); PG8_STAGE(PG8_SA(1, 0), cA + kstepA, voffA); PG8_STAGE(PG8_SB(1, 1), cB + hstepB + kstep, voffB);
        PG8_WAIT_V(6); PG8_BAR;
    }
    for (;;) {
        const bool has_next = S.next(ui + 1, nxt);
        const char* nA = has_next ? (const char*)g.A + (size_t)(nxt.pm * g.pmul) * tstepA + g.aoff(nxt.br) : cA; const char* nB = has_next ? (const char*)g.Bt + (size_t)(nxt.pn * g.pmul) * tstepB + (long)nxt.br * g.b_br : cB;
        for (int t = 0; t < nt; t += 2) {
            const bool last = (t == nt - 2);
            const char* a1 = cA + (size_t)(t + 1) * kstepA;
            const char* a2 = last ? nA : cA + (size_t)(t + 2) * kstepA; const char* b2 = last ? nB : cB + (size_t)(t + 2) * kstep;
            const char* a3 = a2 + kstepA; const char* b3 = b2 + kstep;
            if (last && has_next) S.a_ready(nxt);
            if constexpr (SP2) {
            PG8_LDB(B0, 0, 0); PG8_LDB(B1, 0, 1); PG8_SCHED; PG8_LDA(At, 0, 0); PG8_STAGE(PG8_SA(1, 1), a1 + hstepA, voffA);
            PG8_WAIT_V(8); PG8_WAIT_L(0); PG8_BAR; PG8_MMA(0, 0, At, B0); PG8_MMA(0, 1, At, B1); PG8_BAR; PG8_SCHED;
            PG8_LDA(At, 0, 1); PG8_STAGE(PG8_SB(0, 0), b2, voffB); PG8_STAGE(PG8_SB(0, 1), b2 + hstepB, voffB); PG8_STAGE(PG8_SA(0, 0), a2, voffA);
            PG8_WAIT_V(8); PG8_WAIT_L(0); PG8_BAR; PG8_MMA(1, 0, At, B0); PG8_MMA(1, 1, At, B1); PG8_BAR; PG8_SCHED;
            PG8_LDB(B0, 1, 0); PG8_LDB(B1, 1, 1); PG8_SCHED; PG8_LDA(At, 1, 0); PG8_STAGE(PG8_SA(0, 1), a2 + hstepA, voffA);
            PG8_WAIT_V(8); PG8_WAIT_L(0); PG8_BAR; PG8_MMA(0, 0, At, B0); PG8_MMA(0, 1, At, B1); PG8_BAR; PG8_SCHED;
            PG8_LDA(At, 1, 1); PG8_STAGE(PG8_SB(1, 0), b3, voffB); PG8_STAGE(PG8_SB(1, 1), b3 + hstepB, voffB); PG8_STAGE(PG8_SA(1, 0), a3, voffA);
            PG8_WAIT_V(8); PG8_WAIT_L(0); PG8_BAR; PG8_MMA(1, 0, At, B0); PG8_MMA(1, 1, At, B1); PG8_BAR; PG8_SCHED;
            } else {
            PG8_LDB(B0, 0, 0); PG8_SCHED; PG8_LDA(At, 0, 0); PG8_STAGE(PG8_SA(1, 1), a1 + hstepA, voffA);
            PG8_WAIT_L(8); PG8_BAR; PG8_WAIT_L(0); PG8_MMA(0, 0, At, B0); PG8_BAR; PG8_SCHED;
            PG8_LDB(B1, 0, 1); PG8_STAGE(PG8_SB(0, 0), b2, voffB);
            PG8_BAR; PG8_WAIT_L(0); PG8_MMA(0, 1, At, B1); PG8_BAR;
            PG8_LDA(At, 0, 1); PG8_STAGE(PG8_SA(0, 0), a2, voffA);
            PG8_BAR; PG8_WAIT_L(0); PG8_MMA(1, 0, At, B0); PG8_BAR; PG8_SCHED;
            PG8_STAGE(PG8_SB(0, 1), b2 + hstepB, voffB);
            PG8_WAIT_V(6); PG8_BAR; PG8_MMA(1, 1, At, B1); PG8_BAR;
            PG8_LDB(B0, 1, 0); PG8_SCHED; PG8_LDA(At, 1, 0); PG8_STAGE(PG8_SA(0, 1), a2 + hstepA, voffA);
            PG8_WAIT_L(8); PG8_BAR; PG8_WAIT_L(0); PG8_MMA(0, 0, At, B0); PG8_BAR; PG8_SCHED;
            PG8_LDB(B1, 1, 1); PG8_STAGE(PG8_SB(1, 0), b3, voffB);
            PG8_BAR; PG8_WAIT_L(0); PG8_MMA(0, 1, At, B1); PG8_BAR;
            PG8_LDA(At, 1, 1); PG8_STAGE(PG8_SA(1, 0), a3, voffA);
            PG8_BAR; PG8_WAIT_L(0); PG8_MMA(1, 0, At, B0); PG8_BAR; PG8_SCHED;
            PG8_STAGE(PG8_SB(1, 1), b3 + hstepB, voffB);
            PG8_WAIT_V(6); PG8_BAR; PG8_MMA(1, 1, At, B1); PG8_BAR;
            }
        }
        if constexpr (F8) asm volatile("s_nop 15\n\ts_nop 7" ::: "memory");
        if constexpr (ALIGN_EPI) { if (wr == 0) PG8_BAR; }
        if constexpr (!Epi::AFTER_DRAIN) { E(acc, cur, wr, wc, fr, fq);
#if defined(PROBE_EPI2)
            if constexpr (Epi::PROBE2) { asm volatile("" ::: "memory"); E(acc, cur, wr, wc, fr, fq); }
#endif
            S.done(cur); PG8_TRACE_UNIT(); }
        if (!has_next) break;
#pragma unroll
        for (int a = 0; a < 2; ++a)
#pragma unroll
            for (int b = 0; b < 2; ++b)
#pragma unroll
                for (int m = 0; m < 4; ++m)
#pragma unroll
                    for (int n = 0; n < 2; ++n) acc[a][b][m][n] = (f32x4){0.f, 0.f, 0.f, 0.f};
        cur = nxt; cA = nA; cB = nB; ++ui;
        if constexpr (ALIGN_EPI) { if (wr == 1) PG8_BAR; }
    }
    PG8_WAIT_V(0);
    __builtin_amdgcn_s_waitcnt(0);
    if constexpr (!ALIGN_EPI) { if (wr == 0) PG8_BAR; }
    PG8_BAR;
    if constexpr (Epi::AFTER_DRAIN) { E.fused(acc, cur, wr, wc, fr, fq, lds, wid, lane); S.done(cur); PG8_TRACE_UNIT(); }
#undef PG8_SA
#undef PG8_SB
#undef PG8_STAGE
#undef PG8_LDA
#undef PG8_LDB
#undef PG8_MMA
#undef PG8_WAIT_V
#undef PG8_WAIT_L
#undef PG8_BAR
#undef PG8_SCHED
}
}
#define GAS __attribute__((address_space(1)))
#define LAS __attribute__((address_space(3)))
typedef unsigned short bf16;
typedef unsigned v4u __attribute__((ext_vector_type(4)));
typedef float f32x4 __attribute__((ext_vector_type(4)));
typedef short bf16x8 __attribute__((ext_vector_type(8)));
typedef GAS unsigned gu32;
typedef GAS unsigned long long gu64;
#define RLX_AGENT __ATOMIC_RELAXED, __HIP_MEMORY_SCOPE_AGENT
#define LDS_WAIT() asm volatile("s_waitcnt lgkmcnt(0)" ::: "memory")
#define VM_WAIT() asm volatile("s_waitcnt vmcnt(0)" ::: "memory")
__device__ __forceinline__ unsigned long long rt() { return __builtin_amdgcn_s_memrealtime(); }
__device__ __forceinline__ unsigned f2bf(float f) { unsigned u = __builtin_bit_cast(unsigned, f); return (u + 0x7fffu + ((u >> 16) & 1u)) >> 16; }
__device__ __forceinline__ unsigned pk2(float lo, float hi) { return f2bf(lo) | (f2bf(hi) << 16); }

#define XB_TMO      128
#define XB_XCNT(j)  (256  + 64 * (j))
#define XB_XSUB(j)  (1280 + 64 * (j))
#define XB_XGEN(j)  (2304 + 64 * (j))
#define XB_TOP      3328
#define XB_TOPGEN   3392
#define XCD_BAR_WORDS 3456
#define XB_SPIN_CAP (1u << 18)

__device__ __forceinline__ unsigned xb_ld(unsigned* p)              { return __hip_atomic_load(p, __ATOMIC_RELAXED, __HIP_MEMORY_SCOPE_AGENT); }
__device__ __forceinline__ unsigned xb_add(unsigned* p, unsigned v) { return __hip_atomic_fetch_add(p, v, __ATOMIC_RELAXED, __HIP_MEMORY_SCOPE_AGENT); }
__device__ __forceinline__ unsigned xb_xcc_id() { return (unsigned)__builtin_amdgcn_s_getreg((3 << 11) | 20) & 0xFu; }
#define XB_SPIN(cond, bar) do { unsigned _sp = 0; while (cond) { __builtin_amdgcn_s_sleep(1); \
    if ((++_sp & 255u) == 0u) { if (xb_ld(&(bar)[XB_TMO])) break; if (_sp > XB_SPIN_CAP) { atomicAdd(&(bar)[XB_TMO], 1u); break; } } } } while (0)

struct XcdBarrier {
    unsigned* bar; unsigned x;
    volatile LAS unsigned* st;
};

__device__ __forceinline__ XcdBarrier xcd_barrier_post(unsigned* bar, volatile LAS unsigned* st) {
    XcdBarrier b; b.bar = bar; b.x = xb_xcc_id(); b.st = st;
    if (threadIdx.x == 0) (void)xb_add(&bar[XB_XCNT(b.x)], 1u);
    return b;
}
__device__ __forceinline__ void xcd_barrier_complete(unsigned* bar, unsigned x, unsigned& nloc, unsigned& nx) {
    const unsigned G = gridDim.x * gridDim.y * gridDim.z;
    unsigned sum, cnt, mine, sp = 0u;
    for (;;) {
        sum = 0u; cnt = 0u; mine = 0u;
#pragma unroll
        for (unsigned j = 0; j < 16; ++j) { const unsigned c = xb_ld(&bar[XB_XCNT(j)]); sum += c; cnt += (c > 0u) ? 1u : 0u; mine = (j == x) ? c : mine; }
        if (sum == G) break;
        __builtin_amdgcn_s_sleep(1);
        if ((++sp & 255u) == 0u) { if (xb_ld(&bar[XB_TMO])) break; if (sp > XB_SPIN_CAP) { atomicAdd(&bar[XB_TMO], 1u); break; } }
    }
    nloc = mine > 0u ? mine : 1u; nx = cnt > 0u ? cnt : 1u;
}

__device__ __forceinline__ void xcd_barrier(const XcdBarrier& b) {
    asm volatile("s_waitcnt vmcnt(0)" ::: "memory");
    __syncthreads();
    if (threadIdx.x == 0) {
        unsigned* bar = b.bar;
        __builtin_amdgcn_s_waitcnt(0);
        unsigned nloc = b.st[0], nx = b.st[1];
        if (nloc == 0u) { xcd_barrier_complete(bar, b.x, nloc, nx); b.st[0] = nloc; b.st[1] = nx; }
        const unsigned old = xb_add(&bar[XB_XSUB(b.x)], 1u);
        const unsigned gen = old / nloc;
        if (old + 1u == (gen + 1u) * nloc) {
            __builtin_amdgcn_fence(__ATOMIC_RELEASE, "agent");
            asm volatile("s_waitcnt vmcnt(0)" ::: "memory");
            const unsigned og = xb_add(&bar[XB_TOP], 1u);
            const unsigned tg = og / nx;
            if (og + 1u == (tg + 1u) * nx) xb_add(&bar[XB_TOPGEN], 1u);
            else XB_SPIN(xb_ld(&bar[XB_TOPGEN]) == tg, bar);
            __builtin_amdgcn_fence(__ATOMIC_ACQUIRE, "agent");
            xb_add(&bar[XB_XGEN(b.x)], 1u);
            asm volatile("s_waitcnt vmcnt(0)" ::: "memory");
        } else {
            XB_SPIN(xb_ld(&bar[XB_XGEN(b.x)]) == gen, bar);
            __builtin_amdgcn_fence(__ATOMIC_ACQUIRE, "agent");
            asm volatile("s_waitcnt vmcnt(0)" ::: "memory");
        }
    }
    __syncthreads();
}

constexpr int NWAVES = 8;
constexpr int BATCH = 16, SEQ = 2048, DM = 2048, DEPTH = 4, NMEM = 256;
constexpr int T = BATCH * SEQ, TM = BATCH * NMEM;
constexpr int DIN = 11520, DFF = 8192, BW = 1024;
constexpr int C_QA = 0, C_KA = 1024, C_VA = 1152, C_QB = 1280, C_KB = 2304, C_VB = 3328, C_QC = 4352, C_GATE = 5376;
constexpr float LOG2E = 1.4426950408889634f;
constexpr float QS_A = 0.125f * LOG2E, QS_C = 0.0625f * LOG2E;
constexpr float RMS_EPS = 1e-6f, SUBLN_EPS = 1e-5f;

constexpr size_t MiB = 1u << 20;
constexpr size_t WS_CTL = 0, CTL_ZERO_BYTES = 1 * MiB;
constexpr size_t WS_TAB = 1 * MiB;
constexpr int KPAD = 64;
constexpr int LDH = DM + KPAD, LDU = DFF + KPAD, LDB = BW + KPAD;
constexpr size_t WS_WIN = 2 * MiB, WS_WMEM = 49 * MiB, WS_WBR = 58 * MiB, WS_WOUT = 71 * MiB, WS_W1 = 80 * MiB, WS_W2 = 114 * MiB;
constexpr size_t WS_Z = 148 * MiB;
constexpr size_t WS_H = 868 * MiB;
constexpr size_t WS_HM = 1004 * MiB;
constexpr size_t WS_MKV = 1022 * MiB;
constexpr int LD8 = DM + 128;
constexpr size_t WS_W8 = WS_WIN + 24 * MiB;
constexpr size_t WS_H8 = 1038 * MiB;
constexpr size_t WS_X = 1108 * MiB;
constexpr size_t WS_SS = 1242 * MiB;
constexpr size_t WS_RS1 = 1246 * MiB, WS_RS2 = 1247 * MiB;
constexpr size_t WS_STASH = 1248 * MiB;
constexpr int LDC8 = BW + 128;
constexpr size_t WS_OC8 = 1280 * MiB, WS_WBR8 = 1317 * MiB;
constexpr float OC8_SCALE = 8.0f;
constexpr size_t WS_OA8 = 1320 * MiB, WS_WBR8A = 1357 * MiB;
constexpr size_t WS_END = 1360 * MiB;
constexpr int N8_SWA = C_QB;
constexpr float W8_SCALE = 32.0f;
static_assert(WS_WIN + (size_t)DIN * LDH * 2 <= WS_WMEM && WS_WMEM + (size_t)2048 * LDH * 2 <= WS_WBR && WS_WBR + (size_t)3 * DM * LDB * 2 <= WS_WOUT && WS_WOUT + (size_t)DM * LDH * 2 <= WS_W1 &&
              WS_W1 + (size_t)DFF * LDH * 2 <= WS_W2 && WS_W2 + (size_t)DM * LDU * 2 <= WS_Z && WS_Z + (size_t)T * DIN * 2 <= WS_H && WS_Z + (size_t)T * LDU * 2 <= WS_H && WS_H + (size_t)T * LDH * 2 <= WS_HM &&
              WS_HM + (size_t)TM * LDH * 2 <= WS_MKV && WS_MKV + (size_t)TM * 2048 * 2 <= WS_H8 && WS_H8 + (size_t)T * LD8 <= WS_X && WS_X + (size_t)T * LDH * 2 <= WS_SS && WS_SS + (size_t)T * 32 * 4 <= WS_RS1 && WS_RS1 + (size_t)T * 4 <= WS_RS2 && WS_RS2 + (size_t)T * 4 <= WS_STASH && WS_STASH + (size_t)512 * 65536 <= WS_OC8 && WS_OC8 + (size_t)T * LDC8 <= WS_WBR8 && WS_WBR8 + (size_t)DM * LDC8 <= WS_OA8 && WS_OA8 + (size_t)T * LDC8 <= WS_WBR8A && WS_WBR8A + (size_t)DM * LDC8 <= WS_END && WS_WIN + (size_t)C_QC * LDH * 2 <= WS_W8 && WS_W8 + (size_t)(DIN - C_QC + N8_SWA) * LD8 <= WS_WMEM && WS_WMEM + (size_t)2048 * LD8 <= WS_WBR && WS_HM + (size_t)TM * LD8 <= WS_MKV, "d_ws map");
constexpr int CW_BAR = 4096;
constexpr int TAB_A = 0, TAB_B = 2048, TAB_LAM = 3072;

constexpr int RING_OFF = 0, RING_BYTES = 131072;
constexpr int LDSCTL_OFF = RING_BYTES, MISC_OFF = LDSCTL_OFF + 320;
constexpr int LDS_BYTES = 147456;

namespace att {
using bf16x8 = __attribute__((ext_vector_type(8))) short;
using s16x4  = __attribute__((ext_vector_type(4))) short;
using f32x16 = __attribute__((ext_vector_type(16))) float;
using u32x4  = __attribute__((ext_vector_type(4))) unsigned;
#define ATT_SBAR() __builtin_amdgcn_sched_barrier(0)
#ifndef ATT_MFMA_PRIO
#define ATT_MFMA_PRIO 0
#endif
#if ATT_MFMA_PRIO
#define ATT_PRIO(p) __builtin_amdgcn_s_setprio(p)
#else
#define ATT_PRIO(p) do { } while (0)
#endif
constexpr float THR2 = 8.0f;
__device__ __forceinline__ int crow(int r, int hi) { return (r & 3) + 8 * (r >> 2) + 4 * hi; }
__device__ __forceinline__ unsigned cvtpk(float lo, float hi) { unsigned r; asm volatile("v_cvt_pk_bf16_f32 %0, %1, %2" : "=v"(r) : "v"(lo), "v"(hi)); return r; }
template <int DK> __device__ __forceinline__ int kswz(int row, int ch) {
    if (DK == 64) return row * 128 + ((ch ^ ((row >> 1) & 7)) << 4);
    else return row * (DK * 2) + ((ch ^ (row & 15)) << 4);
}
template <int NDB> __device__ __forceinline__ int v_st(int k, int c) { const int kk = (k & ~0xC) | ((k & 4) << 1) | ((k & 8) >> 1); return ((kk >> 3) * NDB + (c >> 5)) * 512 + ((kk & 7) * 32 + (c & 31)) * 2; }
__device__ __forceinline__ int v_rd_base(int lane) { return ((lane & 3) << 3) | (((lane >> 2) & 3) << 6) | (((lane >> 4) & 1) << 5) | (((lane >> 5) & 1) << 8); }
template <int OFF> __device__ __forceinline__ s16x4 tr_read(int vb) { s16x4 r; asm volatile("ds_read_b64_tr_b16 %0, %1 offset:%2" : "=&v"(r) : "v"(vb), "i"(OFF) : "memory"); return r; }

template <int W> struct TileRegs { u32x4 v[(64 * W / 8) / 512]; };
template <int W> __device__ __forceinline__ void tile_load(TileRegs<W>& R, const bf16* g, size_t ld, int tid) {
    constexpr int CPR = W / 8, N = (64 * CPR) / 512;
#pragma unroll
    for (int i = 0; i < N; ++i) { const int n = tid + 512 * i, row = n / CPR, c = n % CPR; const unsigned off = ((unsigned)row * (unsigned)ld + (unsigned)c * 8u) * 2u;
        R.v[i] = *(const GAS u32x4*)((const GAS unsigned char*)g + off); }
}
template <int DK> __device__ __forceinline__ void tile_write_k(const TileRegs<DK>& R, LAS unsigned char* kb, int tid) {
    constexpr int CPR = DK / 8, N = (64 * CPR) / 512;
#pragma unroll
    for (int i = 0; i < N; ++i) { const int n = tid + 512 * i, row = n / CPR, c = n % CPR; *(LAS u32x4*)(kb + kswz<DK>(row, c)) = R.v[i]; }
}
template <int NDB> __device__ __forceinline__ void tile_write_v(const TileRegs<32 * NDB>& R, LAS unsigned char* vb, int tid) {
    constexpr int CPR = 4 * NDB, N = (64 * CPR) / 512;
#pragma unroll
    for (int i = 0; i < N; ++i) { const int n = tid + 512 * i, row = n / CPR, c = n % CPR; *(LAS u32x4*)(vb + v_st<NDB>(row, c * 8)) = R.v[i]; }
}
template <int DK> __device__ __forceinline__ void qkt(f32x16& p0, f32x16& p1, const LAS unsigned char* kb, const bf16x8* qr, int r32, int hi) {
    p0 = f32x16{}; p1 = f32x16{};
    if constexpr (DK == 64) {
        bf16x8 b0[4], b1[4];
#pragma unroll
        for (int d0 = 0; d0 < 4; ++d0) { b0[d0] = *(const LAS bf16x8*)(kb + kswz<DK>(r32, 2 * d0 + hi)); b1[d0] = *(const LAS bf16x8*)(kb + kswz<DK>(32 + r32, 2 * d0 + hi)); }
        asm volatile("s_waitcnt lgkmcnt(0)" ::: "memory"); ATT_SBAR();
        ATT_PRIO(1);
#pragma unroll
        for (int d0 = 0; d0 < 4; ++d0) { p0 = __builtin_amdgcn_mfma_f32_32x32x16_bf16(b0[d0], qr[d0], p0, 0, 0, 0); p1 = __builtin_amdgcn_mfma_f32_32x32x16_bf16(b1[d0], qr[d0], p1, 0, 0, 0); }
        ATT_PRIO(0);
    } else {
#pragma unroll
        for (int d0 = 0; d0 < DK / 16; ++d0) {
            const bf16x8 b0 = *(const LAS bf16x8*)(kb + kswz<DK>(r32, 2 * d0 + hi));
            const bf16x8 b1 = *(const LAS bf16x8*)(kb + kswz<DK>(32 + r32, 2 * d0 + hi));
            p0 = __builtin_amdgcn_mfma_f32_32x32x16_bf16(b0, qr[d0], p0, 0, 0, 0);
            p1 = __builtin_amdgcn_mfma_f32_32x32x16_bf16(b1, qr[d0], p1, 0, 0, 0); }
    }
}
__device__ __forceinline__ void softmax_tile(f32x16& p0, f32x16& p1, float& m_reg, float& l_reg, float& alpha, bf16x8& pa0, bf16x8& pa1, bf16x8& pa2, bf16x8& pa3) {
    float pmax = p0[0];
#pragma unroll
    for (int r = 1; r < 16; ++r) pmax = fmaxf(pmax, p0[r]);
#pragma unroll
    for (int r = 0; r < 16; ++r) pmax = fmaxf(pmax, p1[r]);
    { auto rr = __builtin_amdgcn_permlane32_swap(__float_as_uint(pmax), __float_as_uint(pmax), false, false); pmax = fmaxf(__uint_as_float(rr[0]), __uint_as_float(rr[1])); }
    if (__builtin_expect(__all(pmax - m_reg <= THR2), 1)) { alpha = 1.f; }
    else { const float mn = fmaxf(m_reg, pmax); alpha = __builtin_amdgcn_exp2f(m_reg - mn); m_reg = mn; }
    float ps = 0.f;
#pragma unroll
    for (int r = 0; r < 16; ++r) { p0[r] = __builtin_amdgcn_exp2f(p0[r] - m_reg); ps += p0[r]; }
#pragma unroll
    for (int r = 0; r < 16; ++r) { p1[r] = __builtin_amdgcn_exp2f(p1[r] - m_reg); ps += p1[r]; }
    { auto rr = __builtin_amdgcn_permlane32_swap(__float_as_uint(ps), __float_as_uint(ps), false, false); ps = __uint_as_float(rr[0]) + __uint_as_float(rr[1]); }
    l_reg = l_reg * alpha + ps;
#define ATT_PK4(P, BASE, OUT) do { unsigned a0 = cvtpk(P[BASE + 0], P[BASE + 1]), a1 = cvtpk(P[BASE + 2], P[BASE + 3]);   \
    unsigned b0 = cvtpk(P[BASE + 4], P[BASE + 5]), b1 = cvtpk(P[BASE + 6], P[BASE + 7]);                              \
    auto r0 = __builtin_amdgcn_permlane32_swap(a0, b0, false, false); auto r1 = __builtin_amdgcn_permlane32_swap(a1, b1, false, false); \
    u32x4 w = {r0[0], r1[0], r0[1], r1[1]}; OUT = __builtin_bit_cast(bf16x8, w); } while (0)
    ATT_PK4(p0, 0, pa0); ATT_PK4(p0, 8, pa1); ATT_PK4(p1, 0, pa2); ATT_PK4(p1, 8, pa3);
#undef ATT_PK4
}
__device__ __forceinline__ void partial_sm(f32x16& p0, f32x16& p1, float& m_reg, float& alpha) {
    float pmax = p0[0];
#pragma unroll
    for (int r = 1; r < 16; ++r) pmax = fmaxf(pmax, p0[r]);
#pragma unroll
    for (int r = 0; r < 16; ++r) pmax = fmaxf(pmax, p1[r]);
    { auto rr = __builtin_amdgcn_permlane32_swap(__float_as_uint(pmax), __float_as_uint(pmax), false, false); pmax = fmaxf(__uint_as_float(rr[0]), __uint_as_float(rr[1])); }
    if (__builtin_expect(__all(pmax - m_reg <= THR2), 1)) { alpha = 1.f; }
    else { const float mn = fmaxf(m_reg, pmax); alpha = __builtin_amdgcn_exp2f(m_reg - mn); m_reg = mn; }
#pragma unroll
    for (int r = 0; r < 16; ++r) { p0[r] = __builtin_amdgcn_exp2f(p0[r] - m_reg); p1[r] = p1[r] - m_reg; }
}
__device__ __forceinline__ void finish_sm(f32x16& p0, f32x16& p1, float alpha, float& l_reg, bf16x8& pa0, bf16x8& pa1, bf16x8& pa2, bf16x8& pa3) {
    float ps = 0.f;
#pragma unroll
    for (int r = 0; r < 16; ++r) { p1[r] = __builtin_amdgcn_exp2f(p1[r]); ps += p0[r] + p1[r]; }
    { auto rr = __builtin_amdgcn_permlane32_swap(__float_as_uint(ps), __float_as_uint(ps), false, false); ps = __uint_as_float(rr[0]) + __uint_as_float(rr[1]); }
    l_reg = l_reg * alpha + ps;
#define ATT_PK4(P, BASE, OUT) do { unsigned a0 = cvtpk(P[BASE + 0], P[BASE + 1]), a1 = cvtpk(P[BASE + 2], P[BASE + 3]);   \
    unsigned b0 = cvtpk(P[BASE + 4], P[BASE + 5]), b1 = cvtpk(P[BASE + 6], P[BASE + 7]);                              \
    auto r0 = __builtin_amdgcn_permlane32_swap(a0, b0, false, false); auto r1 = __builtin_amdgcn_permlane32_swap(a1, b1, false, false); \
    u32x4 w = {r0[0], r1[0], r0[1], r1[1]}; OUT = __builtin_bit_cast(bf16x8, w); } while (0)
    ATT_PK4(p0, 0, pa0); ATT_PK4(p0, 8, pa1); ATT_PK4(p1, 0, pa2); ATT_PK4(p1, 8, pa3);
#undef ATT_PK4
}
template <int NDB, int D0> __device__ __forceinline__ void pv_one(f32x16& od, int vb, bf16x8 pa0, bf16x8 pa1, bf16x8 pa2, bf16x8 pa3) {
    constexpr int KS = NDB * 1024, HF = NDB * 512, B = D0 * 512;
    const s16x4 l0 = tr_read<B + 0 * KS>(vb), h0 = tr_read<B + 0 * KS + HF>(vb), l1 = tr_read<B + 1 * KS>(vb), h1 = tr_read<B + 1 * KS + HF>(vb);
    const s16x4 l2 = tr_read<B + 2 * KS>(vb), h2 = tr_read<B + 2 * KS + HF>(vb), l3 = tr_read<B + 3 * KS>(vb), h3 = tr_read<B + 3 * KS + HF>(vb);
    asm volatile("s_waitcnt lgkmcnt(0)" ::: "memory"); ATT_SBAR();
#define ATT_PK(L, H) (bf16x8){L[0], L[1], L[2], L[3], H[0], H[1], H[2], H[3]}
    od = __builtin_amdgcn_mfma_f32_32x32x16_bf16(pa0, ATT_PK(l0, h0), od, 0, 0, 0);
    od = __builtin_amdgcn_mfma_f32_32x32x16_bf16(pa1, ATT_PK(l1, h1), od, 0, 0, 0);
    od = __builtin_amdgcn_mfma_f32_32x32x16_bf16(pa2, ATT_PK(l2, h2), od, 0, 0, 0);
    od = __builtin_amdgcn_mfma_f32_32x32x16_bf16(pa3, ATT_PK(l3, h3), od, 0, 0, 0);
#undef ATT_PK
}
template <int NDB, int D0> __device__ __forceinline__ void pv_reads(s16x4 (&t)[8], int vb) {
    constexpr int KS = NDB * 1024, HF = NDB * 512, B = D0 * 512;
    t[0] = tr_read<B + 0 * KS>(vb); t[1] = tr_read<B + 0 * KS + HF>(vb); t[2] = tr_read<B + 1 * KS>(vb); t[3] = tr_read<B + 1 * KS + HF>(vb);
    t[4] = tr_read<B + 2 * KS>(vb); t[5] = tr_read<B + 2 * KS + HF>(vb); t[6] = tr_read<B + 3 * KS>(vb); t[7] = tr_read<B + 3 * KS + HF>(vb);
}
__device__ __forceinline__ void pv_mfma(f32x16& od, const s16x4 (&t)[8], bf16x8 pa0, bf16x8 pa1, bf16x8 pa2, bf16x8 pa3) {
#define ATT_PK(L, H) (bf16x8){L[0], L[1], L[2], L[3], H[0], H[1], H[2], H[3]}
    ATT_PRIO(1);
    od = __builtin_amdgcn_mfma_f32_32x32x16_bf16(pa0, ATT_PK(t[0], t[1]), od, 0, 0, 0);
    od = __builtin_amdgcn_mfma_f32_32x32x16_bf16(pa1, ATT_PK(t[2], t[3]), od, 0, 0, 0);
    od = __builtin_amdgcn_mfma_f32_32x32x16_bf16(pa2, ATT_PK(t[4], t[5]), od, 0, 0, 0);
    od = __builtin_amdgcn_mfma_f32_32x32x16_bf16(pa3, ATT_PK(t[6], t[7]), od, 0, 0, 0);
    ATT_PRIO(0);
#undef ATT_PK
}
#define ATT_LGKM(n) asm volatile("s_waitcnt lgkmcnt(" #n ")" ::: "memory")
template <int NDB> __device__ __forceinline__ void pv_pipe4(f32x16 (&o)[4], int vb, bf16x8 pa0, bf16x8 pa1, bf16x8 pa2, bf16x8 pa3) {
    s16x4 ta[8], tb[8];
    pv_reads<NDB, 0>(ta, vb); pv_reads<NDB, 1>(tb, vb);
    ATT_LGKM(8); ATT_SBAR(); pv_mfma(o[0], ta, pa0, pa1, pa2, pa3);
    pv_reads<NDB, 2>(ta, vb);
    ATT_LGKM(8); ATT_SBAR(); pv_mfma(o[1], tb, pa0, pa1, pa2, pa3);
    pv_reads<NDB, 3>(tb, vb);
    ATT_LGKM(8); ATT_SBAR(); pv_mfma(o[2], ta, pa0, pa1, pa2, pa3);
    ATT_LGKM(0); ATT_SBAR(); pv_mfma(o[3], tb, pa0, pa1, pa2, pa3);
}
template <int NDB> __device__ __forceinline__ void pv_pipe2(f32x16 (&o)[2], int vb, bf16x8 pa0, bf16x8 pa1, bf16x8 pa2, bf16x8 pa3) {
    s16x4 ta[8], tb[8];
    pv_reads<NDB, 0>(ta, vb); pv_reads<NDB, 1>(tb, vb);
    ATT_LGKM(8); ATT_SBAR(); pv_mfma(o[0], ta, pa0, pa1, pa2, pa3);
    ATT_LGKM(0); ATT_SBAR(); pv_mfma(o[1], tb, pa0, pa1, pa2, pa3);
}
template <int NO> __device__ __forceinline__ void rescale_o(f32x16 (&o)[NO], float alpha, LAS float* al_l, int r32, int hi) {
    if (__any(alpha < 1.f)) { if (hi == 0) al_l[r32] = alpha; asm volatile("s_waitcnt lgkmcnt(0)" ::: "memory");
#pragma unroll
        for (int r = 0; r < 16; ++r) { const float a = al_l[crow(r, hi)];
#pragma unroll
            for (int d = 0; d < NO; ++d) o[d][r] *= a; } }
}
__device__ __forceinline__ void rows_bcast(float v, float (&out)[16], LAS float* li_l, int r32, int hi) {
    if (hi == 0) li_l[r32] = v; asm volatile("s_waitcnt lgkmcnt(0)" ::: "memory");
#pragma unroll
    for (int r = 0; r < 16; ++r) out[r] = li_l[crow(r, hi)];
}
template <int NO, int QN = 0> __device__ __forceinline__ void store_rows(LAS unsigned char* stg, const f32x16 (&o)[NO], const float (&rs)[16], const float (&cs)[NO], bf16* Og, size_t ld, int lane) {
    constexpr int RB = 64 * NO;
    const int r32 = lane & 31, hi = lane >> 5;
    LAS unsigned char* wp = stg + hi * 4 * RB + r32 * 2;
#pragma unroll
    for (int d = 0; d < NO; ++d)
#pragma unroll
        for (int r = 0; r < 16; ++r) { float v_ = o[d][r] * rs[r] * cs[d]; if (QN > 0) v_ = __uint_as_float((__float_as_uint(v_) + (0x00400000u >> QN)) & ~((0x00800000u >> QN) - 1u)); *(LAS bf16*)(wp + ((r & 3) + 8 * (r >> 2)) * RB + 64 * d) = (bf16)f2bf(v_); }
    asm volatile("s_waitcnt lgkmcnt(0)" ::: "memory");
#pragma unroll
    for (int i = 0; i < 2 * NO; ++i) { const int n = lane + 64 * i, row = n / (4 * NO), c = n % (4 * NO);
        const u32x4 v = *(const LAS u32x4*)(stg + n * 16); *(GAS u32x4*)(Og + (size_t)row * ld + c * 8) = v; }
    asm volatile("s_waitcnt lgkmcnt(0)" ::: "memory");
}
template <int NO> __device__ __forceinline__ void store_rows_f8(LAS unsigned char* stg, const f32x16 (&o)[NO], const float (&rs)[16], float sc8, unsigned char* Og, size_t ld, int lane) {
    constexpr int RB = 32 * NO;
    const int r32 = lane & 31, hi = lane >> 5;
    LAS unsigned char* wp = stg + hi * 4 * RB + r32;
#pragma unroll
    for (int d = 0; d < NO; ++d)
#pragma unroll
        for (int r = 0; r < 16; ++r) { const float v_ = o[d][r] * rs[r] * sc8; const int q_ = __builtin_amdgcn_cvt_pk_fp8_f32(v_, v_, 0, false); *(LAS unsigned char*)(wp + ((r & 3) + 8 * (r >> 2)) * RB + 32 * d) = (unsigned char)q_; }
    asm volatile("s_waitcnt lgkmcnt(0)" ::: "memory");
#pragma unroll
    for (int i = 0; i < NO; ++i) { const int n = lane + 64 * i, row = n / (2 * NO), c = n % (2 * NO);
        const u32x4 v = *(const LAS u32x4*)(stg + n * 16); *(GAS u32x4*)(Og + (size_t)row * ld + c * 16) = v; }
    asm volatile("s_waitcnt lgkmcnt(0)" ::: "memory");
}
}

struct Frame {
    LAS unsigned char* lds;
    volatile LAS unsigned* MISC;
    gu32* ctl;
    int tid, lane, wave;
    int vcu, G, bx;
    unsigned char* ws;
    float* out;
    decltype(__builtin_amdgcn_kernarg_segment_ptr()) karg;
};
#define CAS __attribute__((address_space(4)))
__device__ __forceinline__ const float* inp(const Frame& F, int i) { const GAS float* p = ((const GAS float* const CAS*)(const CAS void*)F.karg)[i]; return (const float*)p; }
__device__ __forceinline__ int lane_now() { int l; asm volatile("v_mbcnt_lo_u32_b32 %0, -1, 0\n\tv_mbcnt_hi_u32_b32 %0, -1, %0" : "=v"(l)); return l; }
#define WSP(off) ((bf16*)(F.ws + (off)))
#define TABP ((float*)(F.ws + WS_TAB))
#define GW (F.vcu * NWAVES + F.wave)
#define NGW (F.G * NWAVES)
typedef unsigned v2u __attribute__((ext_vector_type(2)));
__device__ __forceinline__ float wave_sum(float v) {
#pragma unroll
    for (int o = 1; o < 64; o <<= 1) v += __shfl_xor(v, o);
    return v;
}
__device__ __forceinline__ float wave_max(float v) {
#pragma unroll
    for (int o = 1; o < 64; o <<= 1) v = fmaxf(v, __shfl_xor(v, o));
    return v;
}
__device__ __forceinline__ float bflo(unsigned w) { return __uint_as_float(w << 16); }
__device__ __forceinline__ float bfhi(unsigned w) { return __uint_as_float(w & 0xffff0000u); }
__device__ __forceinline__ float bf1(bf16 h) { return __uint_as_float(((unsigned)h) << 16); }

__device__ __forceinline__ void p0_transpose_item(const float* W, int K, int N, bf16* WT, int ldw, LAS float* scr, int item, int lane, float sc, const float* gk) {
    const int nblk = N / 32, kb = item / nblk, nb = item % nblk, k0 = 64 * kb, n0 = 32 * nb;
#pragma unroll
    for (int i = 0; i < 8; ++i) { const int kk = 8 * i + (lane >> 3); const f32x4 w = *(const GAS f32x4*)(W + (size_t)(k0 + kk) * N + n0 + 4 * (lane & 7)); const float g_ = gk ? sc * gk[k0 + kk] : sc;
        *(LAS f32x4*)(scr + kk * 36 + 4 * (lane & 7)) = (f32x4){w.x * g_, w.y * g_, w.z * g_, w.w * g_}; }
    LDS_WAIT(); asm volatile("" ::: "memory");
    const int c = lane & 7;
#pragma unroll
    for (int j = 0; j < 4; ++j) { const int n = (lane >> 3) + 8 * j; const LAS float* s = scr + (8 * c) * 36 + n;
        v4u o; o.x = pk2(s[0 * 36], s[1 * 36]); o.y = pk2(s[2 * 36], s[3 * 36]); o.z = pk2(s[4 * 36], s[5 * 36]); o.w = pk2(s[6 * 36], s[7 * 36]);
        *(GAS v4u*)(WT + (size_t)(n0 + n) * ldw + k0 + 8 * c) = o; }
    LDS_WAIT(); asm volatile("" ::: "memory");
}
__device__ __forceinline__ unsigned pk4_fp8(float a, float b, float c, float d) { int r = 0; r = __builtin_amdgcn_cvt_pk_fp8_f32(a, b, r, false); r = __builtin_amdgcn_cvt_pk_fp8_f32(c, d, r, true); return (unsigned)r; }
__device__ __forceinline__ void p0_transpose_item_f8(const float* W, int K, int N, unsigned char* WT8, int ld8, int n_base, LAS float* scr, int item, int lane, float sc, const float* gk) {
    const int nblk = N / 32, kb = item / nblk, nb = item % nblk, k0 = 64 * kb, n0 = 32 * nb;
#pragma unroll
    for (int i = 0; i < 8; ++i) { const int kk = 8 * i + (lane >> 3); const f32x4 w = *(const GAS f32x4*)(W + (size_t)(k0 + kk) * N + n0 + 4 * (lane & 7)); const float g_ = gk ? sc * gk[k0 + kk] : sc;
        *(LAS f32x4*)(scr + kk * 36 + 4 * (lane & 7)) = (f32x4){w.x * g_, w.y * g_, w.z * g_, w.w * g_}; }
    LDS_WAIT(); asm volatile("" ::: "memory");
    const int c = lane & 7;
#pragma unroll
    for (int j = 0; j < 4; ++j) { const int n = (lane >> 3) + 8 * j; const LAS float* s = scr + (8 * c) * 36 + n;
        v2u o; o.x = pk4_fp8(s[0 * 36], s[1 * 36], s[2 * 36], s[3 * 36]); o.y = pk4_fp8(s[4 * 36], s[5 * 36], s[6 * 36], s[7 * 36]);
        *(GAS v2u*)(WT8 + (size_t)(n0 - n_base + n) * ld8 + k0 + 8 * c) = o; }
    LDS_WAIT(); asm volatile("" ::: "memory");
}
__device__ __forceinline__ void rms_row_bf16_f8(const float* xrow, const float* g, bf16* orow, unsigned char* o8row, int lane, float eps) {
    const GAS f32x4* xr = (const GAS f32x4*)xrow + lane; const GAS f32x4* gr = (const GAS f32x4*)g + lane;
    f32x4 v[8]; float s = 0.f;
#pragma unroll
    for (int j = 0; j < 8; ++j) { v[j] = xr[64 * j]; s += (v[j].x * v[j].x + v[j].y * v[j].y) + (v[j].z * v[j].z + v[j].w * v[j].w); }
    const float rs = 1.0f / sqrtf(wave_sum(s) * (1.f / DM) + eps);
    GAS v2u* o8 = (GAS v2u*)orow + lane; GAS unsigned* o4 = (GAS unsigned*)o8row + lane;
#pragma unroll
    for (int j = 0; j < 8; ++j) { const f32x4 gg = gr[64 * j]; const float a = v[j].x * rs * gg.x, b = v[j].y * rs * gg.y, c = v[j].z * rs * gg.z, d = v[j].w * rs * gg.w;
        v2u o; o.x = pk2(a, b); o.y = pk2(c, d); o8[64 * j] = o; o4[64 * j] = pk4_fp8(a, b, c, d); }
}
__device__ __forceinline__ void rms_row_f8(const float* xrow, const float* g, unsigned char* o8row, int lane, float eps) {
    const GAS f32x4* xr = (const GAS f32x4*)xrow + lane; const GAS f32x4* gr = (const GAS f32x4*)g + lane;
    f32x4 v[8]; float s = 0.f;
#pragma unroll
    for (int j = 0; j < 8; ++j) { v[j] = xr[64 * j]; s += (v[j].x * v[j].x + v[j].y * v[j].y) + (v[j].z * v[j].z + v[j].w * v[j].w); }
    const float rs = 1.0f / sqrtf(wave_sum(s) * (1.f / DM) + eps);
    GAS unsigned* o4 = (GAS unsigned*)o8row + lane;
    f32x4 gg[8];
#pragma unroll
    for (int j = 0; j < 8; ++j) gg[j] = gr[64 * j];
    asm volatile("" ::: "memory");
#pragma unroll
    for (int j = 0; j < 8; ++j) o4[64 * j] = pk4_fp8(v[j].x * rs * gg[j].x, v[j].y * rs * gg[j].y, v[j].z * rs * gg[j].z, v[j].w * rs * gg[j].w);
}
__device__ __forceinline__ void rms_row_bf16(const float* xrow, const float* g, bf16* orow, int lane, float eps) {
    const GAS f32x4* xr = (const GAS f32x4*)xrow + lane; const GAS f32x4* gr = (const GAS f32x4*)g + lane;
    f32x4 v[8]; float s = 0.f;
#pragma unroll
    for (int j = 0; j < 8; ++j) { v[j] = xr[64 * j]; s += (v[j].x * v[j].x + v[j].y * v[j].y) + (v[j].z * v[j].z + v[j].w * v[j].w); }
    const float rs = 1.0f / sqrtf(wave_sum(s) * (1.f / DM) + eps);
    GAS v2u* o8 = (GAS v2u*)orow + lane;
    f32x4 gg[8];
#pragma unroll
    for (int j = 0; j < 8; ++j) gg[j] = gr[64 * j];
    asm volatile("" ::: "memory");
#pragma unroll
    for (int j = 0; j < 8; ++j) { v2u o; o.x = pk2(v[j].x * rs * gg[j].x, v[j].y * rs * gg[j].y); o.y = pk2(v[j].z * rs * gg[j].z, v[j].w * rs * gg[j].w); o8[64 * j] = o; }
}
__device__ __forceinline__ void rms_row_f32(const float* xrow, const float* g, float* orow, int lane, float eps) {
    const GAS f32x4* xr = (const GAS f32x4*)xrow + lane; const GAS f32x4* gr = (const GAS f32x4*)g + lane;
    f32x4 v[8]; float s = 0.f;
#pragma unroll
    for (int j = 0; j < 8; ++j) { v[j] = xr[64 * j]; s += (v[j].x * v[j].x + v[j].y * v[j].y) + (v[j].z * v[j].z + v[j].w * v[j].w); }
    const float rs = 1.0f / sqrtf(wave_sum(s) * (1.f / DM) + eps);
    GAS f32x4* o = (GAS f32x4*)orow + lane;
#pragma unroll
    for (int j = 0; j < 8; ++j) { const f32x4 gg = gr[64 * j]; o[64 * j] = (f32x4){v[j].x * rs * gg.x, v[j].y * rs * gg.y, v[j].z * rs * gg.z, v[j].w * rs * gg.w}; }
}
__device__ __forceinline__ int t5_bucket(int n) {
    if (n < 16) return n < 0 ? 0 : n;
    int b = 16;
    b += (n >= 19) + (n >= 21) + (n >= 24) + (n >= 27) + (n >= 31) + (n >= 35) + (n >= 40) + (n >= 46) + (n >= 52) + (n >= 59) + (n >= 67) + (n >= 77) + (n >= 87) + (n >= 99) + (n >= 113);
    return b;
}
__device__ __forceinline__ void x0_row(const float* xrow, bf16* orow, unsigned char* o8row, float* rs, int lane, float eps) {
    const GAS f32x4* xr = (const GAS f32x4*)xrow + lane;
    f32x4 v[8]; float s = 0.f;
#pragma unroll
    for (int j = 0; j < 8; ++j) { v[j] = xr[64 * j]; s += (v[j].x * v[j].x + v[j].y * v[j].y) + (v[j].z * v[j].z + v[j].w * v[j].w); }
    const float r = 1.0f / sqrtf(wave_sum(s) * (1.f / DM) + eps);
    if (lane == 0) *(GAS float*)rs = r;
    GAS v2u* o8 = (GAS v2u*)orow + lane; GAS unsigned* o4 = (GAS unsigned*)o8row + lane;
#pragma unroll
    for (int j = 0; j < 8; ++j) { v2u o; o.x = pk2(v[j].x, v[j].y); o.y = pk2(v[j].z, v[j].w); o8[64 * j] = o; o4[64 * j] = pk4_fp8(v[j].x, v[j].y, v[j].z, v[j].w); }
}
__device__ __forceinline__ void x8_row(const bf16* xrow, unsigned char* o8row, int lane) {
    const GAS v2u* xr = (const GAS v2u*)xrow + lane; GAS unsigned* o4 = (GAS unsigned*)o8row + lane;
    v2u w[8];
#pragma unroll
    for (int j = 0; j < 8; ++j) w[j] = xr[64 * j];
#pragma unroll
    for (int j = 0; j < 8; ++j) o4[64 * j] = pk4_fp8(bflo(w[j].x), bfhi(w[j].x), bflo(w[j].y), bfhi(w[j].y));
}
__device__ __forceinline__ void rs_from_ss(Frame& F, float* rs) {
    const GAS f32x4* ss = (const GAS f32x4*)(F.ws + WS_SS);
    for (int r = (F.vcu * NWAVES + F.wave) * 64 + F.lane; r < T; r += F.G * NWAVES * 64) { float s = 0.f;
#pragma unroll
        for (int j = 0; j < 8; ++j) { const f32x4 p = ss[(size_t)r * 8 + j]; s += (p.x + p.y) + (p.z + p.w); }
        ((GAS float*)rs)[r] = 1.0f / sqrtf(s * (1.f / DM) + RMS_EPS); }
}
__device__ __forceinline__ void final_row(Frame& F, int row, const float* g, float* orow) {
    const float p = (F.lane < 32) ? ((const GAS float*)(F.ws + WS_SS))[(size_t)row * 32 + F.lane] : 0.f;
    const float rs = 1.0f / sqrtf(wave_sum(p) * (1.f / DM) + RMS_EPS);
    const GAS v2u* xr = (const GAS v2u*)(WSP(WS_X) + (size_t)row * LDH) + F.lane; const GAS f32x4* gr = (const GAS f32x4*)g + F.lane; GAS f32x4* o = (GAS f32x4*)orow + F.lane;
    v2u w[8]; f32x4 gg[8];
#pragma unroll
    for (int j = 0; j < 8; ++j) { w[j] = xr[64 * j]; gg[j] = gr[64 * j]; }
    asm volatile("" ::: "memory");
#pragma unroll
    for (int j = 0; j < 8; ++j) o[64 * j] = (f32x4){bflo(w[j].x) * rs * gg[j].x, bfhi(w[j].x) * rs * gg[j].y, bflo(w[j].y) * rs * gg[j].z, bfhi(w[j].y) * rs * gg[j].w};
}
__device__ __forceinline__ void phase_a(Frame& F, int l, const float* xin) {
    LAS float* scr = (LAS float*)(F.lds + RING_OFF + F.wave * 16384);
    const int gw = GW;
    constexpr int I_IN = (DM / 64) * (DIN / 32), I_MEM = (DM / 64) * (2048 / 32), I_BR = (BW / 64) * (DM / 32), I_OUT = (DM / 64) * (DM / 32), I_1 = (DM / 64) * (DFF / 32), I_2 = (DFF / 64) * (DM / 32);
    constexpr int NITEMS = I_IN + I_MEM + 3 * I_BR + I_OUT + I_1 + I_2;
    const float* w_in = inp(F, 4) + (size_t)l * DM * DIN; const float* w_mem = inp(F, 13) + (size_t)l * DM * 2048; const float* w_br = inp(F, 14) + (size_t)l * 3 * BW * DM;
    const float* w_out = inp(F, 15) + (size_t)l * DM * DM; const float* w_1 = inp(F, 17) + (size_t)l * DM * DFF; const float* w_2 = inp(F, 18) + (size_t)l * DFF * DM;
    for (int it = gw; it < NITEMS; it += NGW) {
        int r = it;
        if (r < I_IN) { const int n0 = 32 * (r % (DIN / 32));
            if (n0 >= C_QC) { p0_transpose_item_f8(w_in, DM, DIN, (unsigned char*)(F.ws + WS_W8), LD8, C_QC - N8_SWA, scr, r, F.lane, W8_SCALE, inp(F, 3) + (size_t)l * DM); continue; }
            if (n0 < N8_SWA) { p0_transpose_item_f8(w_in, DM, DIN, (unsigned char*)(F.ws + WS_W8), LD8, 0, scr, r, F.lane, W8_SCALE, inp(F, 3) + (size_t)l * DM); continue; }
            const float sc = (n0 < C_KA) ? QS_A : (n0 >= C_QB && n0 < C_KB) ? QS_A : 1.0f;
            p0_transpose_item(w_in, DM, DIN, WSP(WS_WIN), LDH, scr, r, F.lane, sc, inp(F, 3) + (size_t)l * DM); continue; } r -= I_IN;
        if (r < I_MEM) { p0_transpose_item_f8(w_mem, DM, 2048, (unsigned char*)(F.ws + WS_WMEM), LD8, 0, scr, r, F.lane, W8_SCALE, nullptr); continue; } r -= I_MEM;
        if (r < 3 * I_BR) { const int b = r / I_BR;
            if (b == 2) { p0_transpose_item_f8(w_br + (size_t)2 * BW * DM, BW, DM, (unsigned char*)(F.ws + WS_WBR8), LDC8, 0, scr, r - 2 * I_BR, F.lane, W8_SCALE, nullptr); continue; }
            p0_transpose_item(w_br + (size_t)b * BW * DM, BW, DM, WSP(WS_WBR) + (size_t)b * DM * LDB, LDB, scr, r - b * I_BR, F.lane, 1.0f, nullptr); continue; } r -= 3 * I_BR;
        if (r < I_OUT) { p0_transpose_item(w_out, DM, DM, WSP(WS_WOUT), LDH, scr, r, F.lane, 1.0f, nullptr); continue; } r -= I_OUT;
        if (r < I_1) { p0_transpose_item(w_1, DM, DFF, WSP(WS_W1), LDH, scr, r, F.lane, 1.0f, inp(F, 16) + (size_t)l * DM); continue; } r -= I_1;
        p0_transpose_item(w_2, DFF, DM, WSP(WS_W2), LDU, scr, r, F.lane, 1.0f, nullptr);
    }
    if (l == 0) { for (int m = gw; m < T; m += NGW) x0_row(xin + (size_t)m * DM, WSP(WS_X) + (size_t)m * LDH, (unsigned char*)(F.ws + WS_H8) + (size_t)m * LD8, (float*)(F.ws + WS_RS1) + m, F.lane, RMS_EPS); }
    else rs_from_ss(F, (float*)(F.ws + WS_RS1));
    for (int m = gw; m < TM; m += NGW) rms_row_f8(inp(F, 1) + (size_t)m * DM, inp(F, 12) + (size_t)l * DM, (unsigned char*)(F.ws + WS_HM) + (size_t)m * LD8, F.lane, RMS_EPS);
    if (blockIdx.x == 0) {
        const float* rb = inp(F, 2);
        if (l == 0) {
            for (int i = F.tid; i < 16 * 128; i += NWAVES * 64) { const int h = i >> 7, d = i & 127; TABP[TAB_A + i] = rb[t5_bucket(d) * 24 + h] * LOG2E; }
            for (int i = F.tid; i < 8 * 128; i += NWAVES * 64) { const int h = i >> 7, d = i & 127; TABP[TAB_B + i] = rb[t5_bucket(d) * 24 + 16 + h] * LOG2E; }
        }
        if (F.wave == 0) {
            const float a = wave_sum(inp(F, 7)[l * 64 + F.lane] * inp(F, 8)[l * 64 + F.lane]), b = wave_sum(inp(F, 9)[l * 64 + F.lane] * inp(F, 10)[l * 64 + F.lane]);
            const float lam_init = 0.8f - 0.6f * expf(-0.3f * (float)l);
            if (F.lane == 0) TABP[TAB_LAM + l] = expf(a) - expf(b) + lam_init;
        }
    }
}

__device__ __forceinline__ void swa_naive_item(Frame& F, int t, int h, float sink2, LAS float* scr) {
    const int lane = F.lane, s = t & (SEQ - 1), hk = h >> 3;
    bf16* zrow = WSP(WS_Z) + (size_t)t * DIN;
    float q[64];
#pragma unroll
    for (int c = 0; c < 8; ++c) { const v4u w = *(const GAS v4u*)(zrow + C_QA + h * 64 + c * 8);
        q[c * 8 + 0] = bflo(w.x); q[c * 8 + 1] = bfhi(w.x); q[c * 8 + 2] = bflo(w.y); q[c * 8 + 3] = bfhi(w.y); q[c * 8 + 4] = bflo(w.z); q[c * 8 + 5] = bfhi(w.z); q[c * 8 + 6] = bflo(w.w); q[c * 8 + 7] = bfhi(w.w); }
    float sc[2];
#pragma unroll
    for (int j = 0; j < 2; ++j) { const int i = lane + 64 * j, kpos = s - 127 + i; const bool valid = kpos >= 0;
        const bf16* krow = WSP(WS_Z) + (size_t)(valid ? t - 127 + i : t) * DIN + C_KA + hk * 64; float d = 0.f;
#pragma unroll
        for (int c = 0; c < 8; ++c) { const v4u w = *(const GAS v4u*)(krow + c * 8);
            d += q[c * 8 + 0] * bflo(w.x) + q[c * 8 + 1] * bfhi(w.x) + q[c * 8 + 2] * bflo(w.y) + q[c * 8 + 3] * bfhi(w.y) + q[c * 8 + 4] * bflo(w.z) + q[c * 8 + 5] * bfhi(w.z) + q[c * 8 + 6] * bflo(w.w) + q[c * 8 + 7] * bfhi(w.w); }
        sc[j] = valid ? d + TABP[TAB_A + h * 128 + (127 - i)] : -INFINITY; }
    const float m = fmaxf(wave_max(fmaxf(sc[0], sc[1])), sink2);
    const float p0 = __builtin_amdgcn_exp2f(sc[0] - m), p1 = __builtin_amdgcn_exp2f(sc[1] - m);
    const float den = wave_sum(p0 + p1) + __builtin_amdgcn_exp2f(sink2 - m);
    scr[lane] = p0; scr[lane + 64] = p1;
    float acc = 0.f;
    const int i0 = (s >= 127) ? 0 : 127 - s;
    for (int i = i0; i < 128; ++i) acc += scr[i] * bf1(WSP(WS_Z)[(size_t)(t - 127 + i) * DIN + C_VA + hk * 64 + lane]);
    zrow[C_QA + h * 64 + lane] = (bf16)f2bf(acc / den);
}
__device__ __forceinline__ void diff_naive_item(Frame& F, int t, int h, float lam, float ln_scale, const float* subg, LAS float* scr) {
    const int lane = F.lane, s = t & (SEQ - 1), tb = t - s;
    bf16* zrow = WSP(WS_Z) + (size_t)t * DIN;
    LAS float* sc1 = scr; LAS float* sc2 = scr + 2048;
    float mx[2];
#pragma unroll
    for (int mp = 0; mp < 2; ++mp) {
        float q[64];
#pragma unroll
        for (int c = 0; c < 8; ++c) { const v4u w = *(const GAS v4u*)(zrow + C_QB + h * 128 + mp * 64 + c * 8);
            q[c * 8 + 0] = bflo(w.x); q[c * 8 + 1] = bfhi(w.x); q[c * 8 + 2] = bflo(w.y); q[c * 8 + 3] = bfhi(w.y); q[c * 8 + 4] = bflo(w.z); q[c * 8 + 5] = bfhi(w.z); q[c * 8 + 6] = bflo(w.w); q[c * 8 + 7] = bfhi(w.w); }
        LAS float* sc = mp ? sc2 : sc1; float m = -INFINITY;
        for (int c0 = 0; c0 <= s; c0 += 64) { const int key = c0 + lane; const bool valid = key <= s;
            const bf16* krow = WSP(WS_Z) + (size_t)(tb + (valid ? key : s)) * DIN + C_KB + h * 128 + mp * 64; float d = 0.f;
#pragma unroll
            for (int c = 0; c < 8; ++c) { const v4u w = *(const GAS v4u*)(krow + c * 8);
                d += q[c * 8 + 0] * bflo(w.x) + q[c * 8 + 1] * bfhi(w.x) + q[c * 8 + 2] * bflo(w.y) + q[c * 8 + 3] * bfhi(w.y) + q[c * 8 + 4] * bflo(w.z) + q[c * 8 + 5] * bfhi(w.z) + q[c * 8 + 6] * bflo(w.w) + q[c * 8 + 7] * bfhi(w.w); }
            const int dist = s - key; const float v = valid ? d + TABP[TAB_B + h * 128 + (dist > 127 ? 127 : dist)] : -INFINITY;
            sc[key] = v; m = fmaxf(m, v); }
        mx[mp] = wave_max(m);
    }
    float l1 = 0.f, l2 = 0.f;
    for (int c0 = 0; c0 <= s; c0 += 64) { const int key = c0 + lane; const float a = __builtin_amdgcn_exp2f(sc1[key] - mx[0]), b = __builtin_amdgcn_exp2f(sc2[key] - mx[1]); sc1[key] = a; sc2[key] = b; l1 += a; l2 += b; }
    l1 = wave_sum(l1); l2 = wave_sum(l2);
    const float r1 = 1.0f / l1, r2 = lam / l2;
    for (int c0 = 0; c0 <= s; c0 += 64) { const int key = c0 + lane; sc1[key] = sc1[key] * r1 - sc2[key] * r2; }
    float a0 = 0.f, a1 = 0.f;
    const bf16* vb = WSP(WS_Z) + (size_t)tb * DIN + C_VB + h * 128 + 2 * lane;
    for (int key = 0; key <= s; ++key) { const unsigned w = *(const GAS unsigned*)(vb + (size_t)key * DIN); const float a = sc1[key]; a0 += a * bflo(w); a1 += a * bfhi(w); }
    const float ss = wave_sum(a0 * a0 + a1 * a1) * (1.0f / 128.0f);
    const float rs = ln_scale / sqrtf(ss + SUBLN_EPS);
    *(GAS unsigned*)(zrow + C_QB + h * 128 + 2 * lane) = pk2(a0 * rs * subg[2 * lane], a1 * rs * subg[2 * lane + 1]);
}
__device__ __forceinline__ void mem_naive_item(Frame& F, int t, int hc, LAS float* scr) {
    const int lane = F.lane, b = t >> 11;
    bf16* zrow = WSP(WS_Z) + (size_t)t * DIN;
    LAS float* qs = scr; LAS float* ps = scr + 256;
    { const v2u w = *(const GAS v2u*)(zrow + C_QC + hc * 256 + 4 * lane); qs[4 * lane + 0] = bflo(w.x); qs[4 * lane + 1] = bfhi(w.x); qs[4 * lane + 2] = bflo(w.y); qs[4 * lane + 3] = bfhi(w.y); }
    float d[4] = {0.f, 0.f, 0.f, 0.f};
    const bf16* kb = WSP(WS_MKV) + (size_t)(b * NMEM + lane) * 2048 + hc * 256;
    for (int c = 0; c < 32; ++c) {
        float q[8];
#pragma unroll
        for (int e = 0; e < 8; ++e) q[e] = qs[c * 8 + e];
#pragma unroll
        for (int j = 0; j < 4; ++j) { const v4u w = *(const GAS v4u*)(kb + (size_t)(64 * j) * 2048 + c * 8);
            d[j] += q[0] * bflo(w.x) + q[1] * bfhi(w.x) + q[2] * bflo(w.y) + q[3] * bfhi(w.y) + q[4] * bflo(w.z) + q[5] * bfhi(w.z) + q[6] * bflo(w.w) + q[7] * bfhi(w.w); }
    }
    const float m = wave_max(fmaxf(fmaxf(d[0], d[1]), fmaxf(d[2], d[3])));
    float sum = 0.f;
#pragma unroll
    for (int j = 0; j < 4; ++j) { const float p = __builtin_amdgcn_exp2f(d[j] - m); ps[lane + 64 * j] = p; sum += p; }
    sum = wave_sum(sum);
    float a0 = 0.f, a1 = 0.f, a2 = 0.f, a3 = 0.f;
    const bf16* vb = WSP(WS_MKV) + (size_t)(b * NMEM) * 2048 + 1024 + hc * 256 + 4 * lane;
    for (int key = 0; key < NMEM; ++key) { const v2u w = *(const GAS v2u*)(vb + (size_t)key * 2048); const float p = ps[key]; a0 += p * bflo(w.x); a1 += p * bfhi(w.x); a2 += p * bflo(w.y); a3 += p * bfhi(w.y); }
    const float r = 1.0f / sum;
    v2u o; o.x = pk2(a0 * r, a1 * r); o.y = pk2(a2 * r, a3 * r);
    *(GAS v2u*)(zrow + C_QC + hc * 256 + 4 * lane) = o;
}


constexpr int SCR_OFF = LDSCTL_OFF + 1024;
constexpr int TBL_OFF = LDSCTL_OFF + 4096;
constexpr int DIFF_STASH = 49152;
static_assert(TBL_OFF + 8 * 224 * 4 <= LDS_BYTES, "attention LDS map");

template <int VAR = 0>
__device__ __forceinline__ void diff_unit(Frame& F, int b, int h, int qb, float lam, float ln_scale, const float* subg, bf16* Ob, size_t ldo) {
    using namespace att;
    const int tid_ = lane_now() + 64 * F.wave;
    const int tid = tid_, lane = tid & 63, wid = F.wave, r32 = lane & 31, hi = lane >> 5;
    LAS unsigned char* L = F.lds;
    LAS float* tbl = (LAS float*)(L + TBL_OFF);
    LAS float* al_l = (LAS float*)(L + SCR_OFF + wid * 256); LAS float* li_l = al_l + 32;
    GAS u32x4* stash = (GAS u32x4*)(F.ws + WS_STASH + (size_t)F.bx * 65536 + wid * 8192) + lane;
    { const float* TB = TABP + TAB_B + h * 128;
      if (tid < 208) { const int dist = tid - 94; tbl[tid] = dist < 0 ? -INFINITY : (dist > 112 ? 0.f : TB[dist] - TB[127]); } }
    const int q0 = qb * 256, qw = q0 + 32 * wid;
    const bf16* Zb = WSP(WS_Z) + (size_t)b * SEQ * DIN;
    const int NT = 4 * (qb + 1);
    const int lbase = (int)(unsigned)(size_t)L;
    constexpr int KS = 8192, VS = 16384, VOFF = 3 * KS;
    __syncthreads();
#pragma unroll 1
    for (int mp = 0; mp < 2; ++mp) {
        const bf16* Kg = Zb + C_KB + h * 128 + mp * 64; const bf16* Vg = Zb + C_VB + h * 128;
        bf16x8 qr[4];
        { int rq_ = r32; asm volatile("" : "+v"(rq_));
          const bf16* Qw = Zb + (size_t)(qw + rq_) * DIN + C_QB + h * 128 + mp * 64 + hi * 8;
#pragma unroll
          for (int d0 = 0; d0 < 4; ++d0) qr[d0] = *(const GAS bf16x8*)(Qw + d0 * 16); }
        float m_reg = -1e30f, l_reg = 0.f; f32x16 o[4];
#pragma unroll
        for (int d = 0; d < 4; ++d) o[d] = f32x16{};
        TileRegs<64> kr; TileRegs<128> vr;
        f32x16 pA0, pA1, pB0, pB1; float alA = 1.f, alB = 1.f; bf16x8 pa0, pa1, pa2, pa3;
#define DIFF_MASK(P0, P1, J) do { if (64 * (J) + 63 + 113 > qw) { int rr_ = r32 - 4 * hi; asm volatile("" : "+v"(rr_)); const int base_ = qw - 64 * (J) + 94 + rr_;     \
            _Pragma("unroll") for (int r = 0; r < 16; ++r) { int i0 = base_ - ((r & 3) + 8 * (r >> 2)), i1 = i0 - 32; i0 = i0 > 207 ? 207 : (i0 < 0 ? 0 : i0); i1 = i1 > 207 ? 207 : (i1 < 0 ? 0 : i1); P0[r] += tbl[i0]; P1[r] += tbl[i1]; } } } while (0)
#define DIFF_PV(SL) do { const int vb_ = lbase + VOFF + (SL) * VS + v_rd_base(lane); \
            pv_pipe4<4>(o, vb_, pa0, pa1, pa2, pa3); } while (0)
#define DIFF_STEP(PC0, PC1, ALC, PP0, PP1, ALP, J, SC, SP, SN) do { \
            if (VAR != 4 && (J) + 1 < NT) { tile_load<64>(kr, Kg + (size_t)((J) + 1) * 64 * DIN, DIN, tid); tile_load<128>(vr, Vg + (size_t)((J) + 1) * 64 * DIN, DIN, tid); } \
            ATT_SBAR(); if constexpr (VAR != 3) qkt<64>(PC0, PC1, L + (SC) * KS, qr, r32, hi); \
            if constexpr (VAR != 2) finish_sm(PP0, PP1, ALP, l_reg, pa0, pa1, pa2, pa3); ATT_SBAR(); \
            DIFF_MASK(PC0, PC1, J); ATT_SBAR(); \
            if constexpr (VAR != 1) DIFF_PV(SP); \
            if constexpr (VAR != 2) { partial_sm(PC0, PC1, m_reg, ALC); ATT_SBAR(); rescale_o<4>(o, ALC, al_l, r32, hi); } ATT_SBAR(); \
            if (VAR != 4 && (J) + 1 < NT) { tile_write_k<64>(kr, L + (SN) * KS, tid); tile_write_v<4>(vr, L + VOFF + (SN) * VS, tid); } \
            __syncthreads(); } while (0)
        tile_load<64>(kr, Kg, DIN, tid); tile_load<128>(vr, Vg, DIN, tid);
        tile_write_k<64>(kr, L, tid); tile_write_v<4>(vr, L + VOFF, tid);
        __syncthreads();
        tile_load<64>(kr, Kg + (size_t)64 * DIN, DIN, tid); tile_load<128>(vr, Vg + (size_t)64 * DIN, DIN, tid);
        qkt<64>(pA0, pA1, L, qr, r32, hi); DIFF_MASK(pA0, pA1, 0); partial_sm(pA0, pA1, m_reg, alA);
        tile_write_k<64>(kr, L + KS, tid); tile_write_v<4>(vr, L + VOFF + VS, tid);
        __syncthreads();
        int sc = 1, sp = 0, sn = 2;
#pragma unroll 1
        for (int j = 1; j + 1 < NT; j += 2) {
            DIFF_STEP(pB0, pB1, alB, pA0, pA1, alA, j, sc, sp, sn);
            { const int t_ = sp; sp = sc; sc = sn; sn = t_; }
            DIFF_STEP(pA0, pA1, alA, pB0, pB1, alB, j + 1, sc, sp, sn);
            { const int t_ = sp; sp = sc; sc = sn; sn = t_; }
        }
        DIFF_STEP(pB0, pB1, alB, pA0, pA1, alA, NT - 1, sc, sp, sn);
        finish_sm(pB0, pB1, alB, l_reg, pa0, pa1, pa2, pa3); DIFF_PV(sc);
        __syncthreads();
#undef DIFF_STEP
#undef DIFF_PV
#undef DIFF_MASK
        float rl[16]; rows_bcast(1.0f / l_reg, rl, li_l, r32, hi);
        if (mp == 0) {
#pragma unroll
            for (int d = 0; d < 4; ++d)
#pragma unroll
                for (int q = 0; q < 2; ++q) { u32x4 w; const int r = 8 * q;
                    w.x = cvtpk(o[d][r] * rl[r], o[d][r + 1] * rl[r + 1]); w.y = cvtpk(o[d][r + 2] * rl[r + 2], o[d][r + 3] * rl[r + 3]);
                    w.z = cvtpk(o[d][r + 4] * rl[r + 4], o[d][r + 5] * rl[r + 5]); w.w = cvtpk(o[d][r + 6] * rl[r + 6], o[d][r + 7] * rl[r + 7]);
                    stash[(d * 2 + q) * 64] = w; }
        } else {
            float ss[16];
#pragma unroll
            for (int r = 0; r < 16; ++r) ss[r] = 0.f;
#pragma unroll
            for (int d = 0; d < 4; ++d)
#pragma unroll
                for (int q = 0; q < 2; ++q) { const u32x4 w = stash[(d * 2 + q) * 64]; const unsigned wv[4] = {w.x, w.y, w.z, w.w};
#pragma unroll
                    for (int e = 0; e < 4; ++e) { const int r = 8 * q + 2 * e;
                        const float c0 = bflo(wv[e]) - lam * (o[d][r] * rl[r]), c1 = bfhi(wv[e]) - lam * (o[d][r + 1] * rl[r + 1]);
                        o[d][r] = c0; o[d][r + 1] = c1; ss[r] += c0 * c0; ss[r + 1] += c1 * c1; } }
#pragma unroll
            for (int r = 0; r < 16; ++r) {
#pragma unroll
                for (int off = 1; off < 32; off <<= 1) ss[r] += __shfl_xor(ss[r], off);
                ss[r] = ln_scale / sqrtf(ss[r] * (1.0f / 128.0f) + SUBLN_EPS); }
            int lane_e = lane; asm volatile("" : "+v"(lane_e));
            float cs[4];
#pragma unroll
            for (int d = 0; d < 4; ++d) cs[d] = subg[32 * d + (lane_e & 31)];
            store_rows<4, PROBE_QOB>(L + wid * 8192, o, ss, cs, Ob + ((size_t)b * SEQ + qw) * ldo + h * 128, ldo, lane_e);
        }
    }
}
__device__ __forceinline__ void swa_unit(Frame& F, int b, int hk, int rb, const float* sinks_l, bf16* Ob, size_t ldo, bool fill_tbl, unsigned char* O8) {
    using namespace att;
    const int tid_ = lane_now() + 64 * F.wave;
    const int tid = tid_, lane = tid & 63, wid = F.wave, r32 = lane & 31, hi = lane >> 5;
    LAS unsigned char* L = F.lds;
    LAS float* tbl = (LAS float*)(L + TBL_OFF) + wid * 224;
    LAS float* al_l = (LAS float*)(L + SCR_OFF + wid * 256); LAS float* li_l = al_l + 32;
    const int h = hk * 8 + wid;
    if (fill_tbl) { const float* TA = TABP + TAB_A + hk * 8 * 128; LAS float* tb = (LAS float*)(L + TBL_OFF);
      for (int i = tid; i < 8 * 224; i += NWAVES * 64) { const int w = i / 224, dist = (i - w * 224) - 63; tb[i] = (dist < 0 || dist > 127) ? -INFINITY : TA[w * 128 + dist]; } }
    const int s0 = 64 * rb, a = rb, j0 = a >= 2 ? a - 2 : 0, NT = a - j0 + 1;
    const bf16* Zb = WSP(WS_Z) + (size_t)b * SEQ * DIN;
    const bf16* Kg = Zb + (size_t)j0 * 64 * DIN + C_KA + hk * 64; const bf16* Vg = Zb + (size_t)j0 * 64 * DIN + C_VA + hk * 64;
    const int lbase = (int)(unsigned)(size_t)L;
    const float sink2 = sinks_l[h] * LOG2E;
    __syncthreads();
    bf16x8 qr[2][4];
#pragma unroll
    for (int sb = 0; sb < 2; ++sb) { const bf16* Qw = Zb + (size_t)(s0 + 32 * sb + r32) * DIN + C_QA + h * 64 + hi * 8;
#pragma unroll
      for (int d0 = 0; d0 < 4; ++d0) qr[sb][d0] = *(const GAS bf16x8*)(Qw + d0 * 16); }
    float m_reg[2] = {-1e30f, -1e30f}, l_reg[2] = {0.f, 0.f}; f32x16 o[2][2];
#pragma unroll
    for (int sb = 0; sb < 2; ++sb) { o[sb][0] = f32x16{}; o[sb][1] = f32x16{}; }
    TileRegs<64> kr, vr;
    tile_load<64>(kr, Kg, DIN, tid); tile_load<64>(vr, Vg, DIN, tid);
    tile_write_k<64>(kr, L, tid); tile_write_v<2>(vr, L + 16384, tid);
    __syncthreads();
#pragma unroll 1
    for (int j = 0; j < NT; ++j) {
        const int cur = j & 1;
        if (j + 1 < NT) { tile_load<64>(kr, Kg + (size_t)(j + 1) * 64 * DIN, DIN, tid); tile_load<64>(vr, Vg + (size_t)(j + 1) * 64 * DIN, DIN, tid); }
#pragma unroll
        for (int sb = 0; sb < 2; ++sb) {
            f32x16 p0, p1; qkt<64>(p0, p1, L + cur * 8192, qr[sb], r32, hi);
            int rr_ = r32 - 4 * hi; asm volatile("" : "+v"(rr_));
            const int base = s0 + 32 * sb - 64 * (j0 + j) + 63 + rr_;
#pragma unroll
            for (int r = 0; r < 16; ++r) { const int i0 = base - ((r & 3) + 8 * (r >> 2)), i1 = i0 - 32; p0[r] += tbl[i0 > 222 ? 222 : i0]; p1[r] += tbl[i1 > 222 ? 222 : i1]; }
            float alpha; bf16x8 pa0, pa1, pa2, pa3;
            softmax_tile(p0, p1, m_reg[sb], l_reg[sb], alpha, pa0, pa1, pa2, pa3);
            rescale_o<2>(o[sb], alpha, al_l, r32, hi);
            const int vb = lbase + 16384 + cur * 8192 + v_rd_base(lane);
            pv_pipe2<2>(o[sb], vb, pa0, pa1, pa2, pa3);
        }
        if (j + 1 < NT) { tile_write_k<64>(kr, L + (cur ^ 1) * 8192, tid); tile_write_v<2>(vr, L + 16384 + (cur ^ 1) * 8192, tid); }
        __syncthreads();
    }
#pragma unroll
    for (int sb = 0; sb < 2; ++sb) {
        float rl[16]; rows_bcast(1.0f / (l_reg[sb] + __builtin_amdgcn_exp2f(sink2 - m_reg[sb])), rl, li_l, r32, hi);
        int lane_e = lane; asm volatile("" : "+v"(lane_e)); const float cs[2] = {1.f, 1.f};
        if (O8) store_rows_f8<2>(L + wid * 4096, o[sb], rl, OC8_SCALE, O8 + ((size_t)b * SEQ + s0 + 32 * sb) * LDC8 + h * 64, LDC8, lane_e);
        else store_rows<2, PROBE_QOA>(L + wid * 4096, o[sb], rl, cs, Ob + ((size_t)b * SEQ + s0 + 32 * sb) * ldo + h * 64, ldo, lane_e);
    }
}
__device__ __forceinline__ void mem_unit(Frame& F, int b, int hc, int qb, bf16* Ob, size_t ldo, unsigned char* O8) {
    using namespace att;
    const int tid_ = lane_now() + 64 * F.wave;
    const int tid = tid_, lane = tid & 63, wid = F.wave, r32 = lane & 31, hi = lane >> 5, rw = wid & 3, vh = wid >> 2;
    LAS unsigned char* L = F.lds;
    LAS float* al_l = (LAS float*)(L + SCR_OFF + wid * 256); LAS float* li_l = al_l + 32;
    const int qw = qb * 128 + 32 * rw;
    const bf16* Zb = WSP(WS_Z) + (size_t)b * SEQ * DIN;
    const bf16* Kg = WSP(WS_MKV) + (size_t)b * NMEM * 2048 + hc * 256; const bf16* Vg = Kg + 1024;
    const int lbase = (int)(unsigned)(size_t)L;
    __syncthreads();
    bf16x8 qr[16];
    { const bf16* Qw = Zb + (size_t)(qw + r32) * DIN + C_QC + hc * 256 + hi * 8;
#pragma unroll
      for (int d0 = 0; d0 < 16; ++d0) qr[d0] = *(const GAS bf16x8*)(Qw + d0 * 16); }
    float m_reg = -1e30f, l_reg = 0.f; f32x16 o[4];
#pragma unroll
    for (int d = 0; d < 4; ++d) o[d] = f32x16{};
    TileRegs<256> sr;
    tile_load<256>(sr, Kg, 2048, tid); tile_write_k<256>(sr, L, tid);
    tile_load<256>(sr, Vg, 2048, tid); tile_write_v<8>(sr, L + 65536, tid);
    __syncthreads();
#pragma unroll 1
    for (int j = 0; j < 4; ++j) {
        const int cur = j & 1;
        if (j + 1 < 4) tile_load<256>(sr, Kg + (size_t)(j + 1) * 64 * 2048, 2048, tid);
        f32x16 p0, p1; qkt<256>(p0, p1, L + cur * 32768, qr, r32, hi);
        if (j + 1 < 4) { tile_write_k<256>(sr, L + (cur ^ 1) * 32768, tid); tile_load<256>(sr, Vg + (size_t)(j + 1) * 64 * 2048, 2048, tid); }
        float alpha; bf16x8 pa0, pa1, pa2, pa3;
        softmax_tile(p0, p1, m_reg, l_reg, alpha, pa0, pa1, pa2, pa3);
        rescale_o<4>(o, alpha, al_l, r32, hi);
        const int vb = lbase + 65536 + cur * 32768 + vh * 2048 + v_rd_base(lane);
        pv_pipe4<8>(o, vb, pa0, pa1, pa2, pa3);
        if (j + 1 < 4) tile_write_v<8>(sr, L + 65536 + (cur ^ 1) * 32768, tid);
        __syncthreads();
    }
    float rl[16]; rows_bcast(1.0f / l_reg, rl, li_l, r32, hi);
    { int lane_e = lane; asm volatile("" : "+v"(lane_e)); const float cs[4] = {1.f, 1.f, 1.f, 1.f};
      store_rows<4, PROBE_QOC>(L + wid * 8192, o, rl, cs, Ob + ((size_t)b * SEQ + qw) * ldo + hc * 256 + vh * 128, ldo, lane_e);
      if (O8) store_rows_f8<4>(L + wid * 8192, o, rl, OC8_SCALE, O8 + ((size_t)b * SEQ + qw) * LDC8 + hc * 256 + vh * 128, LDC8, lane_e); }
}
struct Args { const float* in[20]; float* out; unsigned char* ws; };
__global__ void __launch_bounds__(NWAVES * 64, 2) mk_fwd(Args args) {
    extern __shared__ __attribute__((aligned(16))) unsigned char lds[];
    Frame F;
    F.lds = (LAS unsigned char*)lds;
    F.MISC = (volatile LAS unsigned*)(F.lds + MISC_OFF);
    F.tid = threadIdx.x; F.lane = F.tid & 63; F.wave = __builtin_amdgcn_readfirstlane(F.tid >> 6);
    F.G = gridDim.x; { const int bx = blockIdx.x; F.bx = bx; F.vcu = (F.G % 8 == 0) ? (bx % 8) * (F.G / 8) + bx / 8 : bx; }
    F.ws = args.ws; F.out = args.out; F.karg = __builtin_amdgcn_kernarg_segment_ptr();
    F.ctl = (gu32*)(F.ws + WS_CTL);
    for (int u = F.tid; u < (LDS_BYTES - LDSCTL_OFF) / 4; u += NWAVES * 64) ((LAS unsigned*)(F.lds + LDSCTL_OFF))[u] = 0u;
    __syncthreads();
    XcdBarrier bar = xcd_barrier_post((unsigned*)(F.ctl + CW_BAR), F.MISC + 8);
#if defined(PROBE_TRACE)
#define TRACE_P ((GAS unsigned long long*)(F.ws + WS_END))
#define GRID_BAR_K(k) do { __syncthreads(); if (lane_now() == 0 && F.wave == 0) { TRACE_P[((size_t)F.bx * 64 + (k)) * 2] = rt(); TRACE_P[((size_t)F.bx * 64 + 32 + (k)) * 2] = __builtin_readcyclecounter(); } xcd_barrier(bar); if (lane_now() == 0 && F.wave == 0) { TRACE_P[((size_t)F.bx * 64 + (k)) * 2 + 1] = rt(); TRACE_P[((size_t)F.bx * 64 + 32 + (k)) * 2 + 1] = __builtin_readcyclecounter(); } } while (0)
    if (threadIdx.x == 0) { TRACE_P[((size_t)F.bx * 64 + 63) * 2] = rt(); if (F.bx == 0) pg8::g_tn = 0; }
#else
#define GRID_BAR_K(k) xcd_barrier(bar)
#endif
#define PHASE_BEGIN() do { { int w_ = F.wave; asm volatile("" : "+s"(w_)); F.wave = w_; GAS unsigned* bb_ = (GAS unsigned*)bar.bar; asm volatile("" : "+s"(bb_)); bar.bar = (unsigned*)bb_; } int t_ = lane_now() + 64 * F.wave; F.tid = t_; F.lane = t_ & 63;     \
        GAS unsigned char* w_ = (GAS unsigned char*)args.ws; asm volatile("" : "+s"(w_)); F.ws = (unsigned char*)w_; GAS float* o_ = (GAS float*)args.out; asm volatile("" : "+s"(o_)); F.out = (float*)o_; \
        auto k_ = __builtin_amdgcn_kernarg_segment_ptr(); asm volatile("" : "+s"(k_)); F.karg = k_; \
        int g_ = (int)gridDim.x, bx_ = (int)blockIdx.x; asm volatile("" : "+s"(g_), "+s"(bx_)); F.G = g_; F.bx = bx_; F.vcu = (g_ % 8 == 0) ? (bx_ % 8) * (g_ / 8) + bx_ / 8 : bx_; } while (0)

    for (int l = 0; l < DEPTH; ++l) {
        for (int rep = 0; rep < REP_PA; ++rep) {
        PHASE_BEGIN();
        phase_a(F, l, inp(F, 0));
        GRID_BAR_K(l * 7 + 0);
        }
        for (int rep = 0; rep < REP_PB; ++rep) {
        PHASE_BEGIN();
        {
            pg8::Gemm g{WSP(WS_X), WSP(WS_WIN) + (size_t)C_QB * LDH, DM, LDH, LDH, 0, 0, 0, 0, 0, 1};
            pg8::StaticOrder S; S.init(T, C_QC - C_QB, F.G, F.bx, PB_BF_WGM);
            pg8::EpiZ E{1 << 20, 0, 0, 1.0f, WSP(WS_Z) + C_QB, DIN, inp(F, 5) + (size_t)l * 3 * DM, 1 << 20, nullptr, 0, 1.0f, (const float*)(F.ws + WS_RS1), 1.0f};
            pg8::gemm_phase<pg8::EpiZ, pg8::StaticOrder, true, true>(F.lds + RING_OFF, g, S, E, F.tid);
        }
        {
            pg8::Gemm g{(const bf16*)(F.ws + WS_H8), (const bf16*)(F.ws + WS_W8), DM / 2, LD8 / 2, LD8 / 2, (long)WS_HM - (long)WS_H8, 0, (long)WS_WMEM - (long)WS_W8, 0, 0, 1};
            pg8::TwoGemmOrder S; S.init(T, DIN - C_QC + N8_SWA, F.G, F.bx, PB_F8_WGM); S.init2(TM, 2048);
            pg8::EpiZ E{N8_SWA / 256, (C_QC - N8_SWA) / 256, C_KA / 256, QS_A / W8_SCALE, WSP(WS_Z), DIN, inp(F, 5) + (size_t)l * 3 * DM, (C_GATE - C_QC + N8_SWA) / 256, WSP(WS_MKV), 2048, 1.0f / W8_SCALE, (const float*)(F.ws + WS_RS1), QS_C / W8_SCALE};
            pg8::gemm_phase<pg8::EpiZ, pg8::TwoGemmOrder, true, true, true>(F.lds + RING_OFF, g, S, E, F.tid);
        }
        GRID_BAR_K(l * 7 + 1);
        }
        for (int rep = 0; rep < REP_PC; ++rep) {
        PHASE_BEGIN();
        {
            const float* sinks = inp(F, 6) + l * 16;
            const float lam = TABP[TAB_LAM + l]; const float ln_scale = 1.0f - (0.8f - 0.6f * expf(-0.3f * (float)l));
            const float* subg = inp(F, 11) + l * 128;
#if ATT_STATIC_PRIO
            if (F.wave >= 4) __builtin_amdgcn_s_setprio(1);
#endif
            const bool dmy = rep + 1 < REP_PC;
#if MFMA_DIFF
            for (int xr = 0; xr < XREP_DIFF; ++xr) { PHASE_BEGIN(); for (int u = F.vcu; u < 1024; u += F.G) { const int i = u >> 8, c = u & 255, bh = c >> 1, half = c & 1;
                const int qb = half ? (i == 0 ? 2 : i == 1 ? 5 : i == 2 ? 3 : 4) : (i == 0 ? 0 : i == 1 ? 7 : i == 2 ? 1 : 6);
                diff_unit<XVAR_DIFF>(F, bh >> 3, bh & 7, qb, lam, ln_scale, subg, WSP(WS_H), (size_t)DM); } PHASE_BEGIN(); }
            for (int u = F.vcu; u < 1024; u += F.G) { const int i = u >> 8, c = u & 255, bh = c >> 1, half = c & 1;
                const int qb = half ? (i == 0 ? 2 : i == 1 ? 5 : i == 2 ? 3 : 4) : (i == 0 ? 0 : i == 1 ? 7 : i == 2 ? 1 : 6);
                diff_unit(F, bh >> 3, bh & 7, qb, lam, ln_scale, subg, dmy ? WSP(WS_H) : WSP(WS_Z) + C_QB, dmy ? (size_t)DM : (size_t)DIN); }
#endif
#if defined(PROBE_TRACE)
            if (F.bx == 0 && lane_now() == 0 && F.wave == 0) pg8::g_tu[256 + l * 4 + 0] = rt();
#endif
#if MFMA_SWA
            for (int xr = 0; xr < XREP_SWA; ++xr) for (int u = F.vcu; u < 1024; u += F.G) swa_unit(F, u >> 6, (u >> 5) & 1, u & 31, sinks, WSP(WS_H), (size_t)DM, true, nullptr);
            for (int u = F.vcu; u < 1024; u += F.G) swa_unit(F, u >> 6, (u >> 5) & 1, u & 31, sinks, dmy ? WSP(WS_H) : WSP(WS_Z) + C_QA, dmy ? (size_t)DM : (size_t)DIN, (F.G & 63) != 0 || u == F.vcu, nullptr);
#endif
#if defined(PROBE_TRACE)
            if (F.bx == 0 && lane_now() == 0 && F.wave == 0) pg8::g_tu[256 + l * 4 + 1] = rt();
#endif
#if MFMA_MEM
            for (int xr = 0; xr < XREP_MEM; ++xr) for (int u = F.vcu; u < 1024; u += F.G) mem_unit(F, u >> 6, (u >> 4) & 3, u & 15, WSP(WS_H), (size_t)DM, nullptr);
            for (int u = F.vcu; u < 1024; u += F.G) mem_unit(F, u >> 6, (u >> 4) & 3, u & 15, dmy ? WSP(WS_H) : WSP(WS_Z) + C_QC, dmy ? (size_t)DM : (size_t)DIN, dmy ? nullptr : (unsigned char*)(F.ws + WS_OC8));
#endif
#if ATT_STATIC_PRIO
            __builtin_amdgcn_s_setprio(0);
#endif
#if !MFMA_DIFF || !MFMA_SWA || !MFMA_MEM
            __syncthreads();
            LAS float* scr = (LAS float*)(F.lds + RING_OFF + F.wave * 16384);
            const int gw = GW;
#if !MFMA_SWA
            for (int it = gw; it < T * 16; it += NGW) { const int h = it & 15; swa_naive_item(F, it >> 4, h, sinks[h] * LOG2E, scr); }
#endif
#if !MFMA_DIFF
            for (int it = gw; it < T * 8; it += NGW) diff_naive_item(F, it >> 3, it & 7, lam, ln_scale, subg, scr);
#endif
#if !MFMA_MEM
            for (int it = gw; it < T * 4; it += NGW) mem_naive_item(F, it >> 2, it & 3, scr);
#endif
#endif
        }
        GRID_BAR_K(l * 7 + 2);
        }
        for (int rep = 0; rep < REP_PD; ++rep) {
        PHASE_BEGIN();
#if PD_STAGGER_TICKS
        { const unsigned long long te = rt() + (unsigned long long)(((F.vcu >> PD_STAGGER_SHIFT) & 3) * PD_STAGGER_TICKS); while (rt() < te) __builtin_amdgcn_s_sleep(4); }
#endif
        {
            pg8::Gemm g{WSP(WS_Z) + C_QA, WSP(WS_WBR), BW, DIN, LDB, (long)C_QB * 2, 0, (long)DM * LDB * 2, 0, 0, 1}; pg8::BranchOrder<2> S; S.init(T, DM, F.G, F.bx, PH_WGM);
            pg8::EpiBranch E{WSP(WS_H), LDH, WSP(WS_Z) + C_GATE, DIN, DM, 0, 1, 1, 1.0f};
            pg8::gemm_phase<pg8::EpiBranch, pg8::BranchOrder<2>, true, true>(F.lds + RING_OFF, g, S, E, F.tid);
        }
        {
            pg8::Gemm g{(const bf16*)(F.ws + WS_OC8), (const bf16*)(F.ws + WS_WBR8), BW / 2, LDC8 / 2, LDC8 / 2, 0, 0, 0, 0, 0, 1}; pg8::StaticOrder S; S.init(T, DM, F.G, F.bx, PH_WGM);
            pg8::EpiBranch E{WSP(WS_H), LDH, WSP(WS_Z) + C_GATE, DIN, DM, 2, 0, 0, 1.0f / (W8_SCALE * OC8_SCALE)};
            pg8::gemm_phase<pg8::EpiBranch, pg8::StaticOrder, true, true, true>(F.lds + RING_OFF, g, S, E, F.tid);
        }
        GRID_BAR_K(l * 7 + 3);
        }
        for (int rep = 0; rep < REP_PE; ++rep) {
        PHASE_BEGIN();
        {
            pg8::Gemm g{WSP(WS_H), WSP(WS_WOUT), DM, LDH, LDH, 0, 0, 0, 0, 0, 1}; pg8::StaticOrder S; S.init(T, DM, F.G, F.bx, PH_WGM);
            pg8::EpiResB<false, false> E{WSP(WS_X), LDH, (float*)(F.ws + WS_SS), nullptr, 0, nullptr};
            pg8::gemm_phase<pg8::EpiResB<false, false>, pg8::StaticOrder, true, true>(F.lds + RING_OFF, g, S, E, F.tid);
        }
        GRID_BAR_K(l * 7 + 4);
        }
        for (int rep = 0; rep < REP_PG; ++rep) {
        PHASE_BEGIN();
        {
            rs_from_ss(F, (float*)(F.ws + WS_RS2));
            pg8::Gemm g{WSP(WS_X), WSP(WS_W1), DM, LDH, LDH, 0, 0, 0, 0, 0, 1}; pg8::StaticOrder S; S.init(T, DFF, F.G, F.bx, GEMM_WGM);
            pg8::EpiUTiled E{WSP(WS_Z), DFF / 64};
            pg8::gemm_phase<pg8::EpiUTiled, pg8::StaticOrder, true, true>(F.lds + RING_OFF, g, S, E, F.tid);
        }
        GRID_BAR_K(l * 7 + 5);
        }
#if defined(PROBE_XG)
        PHASE_BEGIN();
        {
            pg8::Gemm g{WSP(WS_X), WSP(WS_W1), DM, LDH, LDH, 0, 0, 0, 0, 0, PROBE_XG}; pg8::StaticOrder S; S.init(T, DM, F.G, F.bx);
            pg8::EpiUTiled E{(bf16*)(F.ws + 664 * MiB), DM / 64};
            pg8::gemm_phase<pg8::EpiUTiled, pg8::StaticOrder, true, true>(F.lds + RING_OFF, g, S, E, F.tid);
        }
        GRID_BAR_K(l * 7 + 5);
#endif
        for (int rep = 0; rep < REP_PH; ++rep) {
        PHASE_BEGIN();
        {
            pg8::Gemm g{WSP(WS_Z), WSP(WS_W2), DFF, 64, LDU, 0, 0, 0, 256 * 64 * 2, (long)(DFF / 64) * 256 * 64 * 2, 1}; pg8::StaticOrder S; S.init(T, DM, F.G, F.bx, PH_WGM);
            pg8::EpiResB<true, true> E{WSP(WS_X), LDH, (float*)(F.ws + WS_SS), (unsigned char*)(F.ws + WS_H8), LD8, (const float*)(F.ws + WS_RS2)};
            pg8::gemm_phase<pg8::EpiResB<true, true>, pg8::StaticOrder, true, true, false, PH_A_AUX>(F.lds + RING_OFF, g, S, E, F.tid);
        }
        GRID_BAR_K(l * 7 + 6);
        }
    }
    PHASE_BEGIN();
    for (int m = GW; m < T; m += NGW) final_row(F, m, inp(F, 19), F.out + (size_t)m * DM);
#if defined(PROBE_TRACE)
    { const int l = 4; GRID_BAR_K(l * 7 + 0); }
    PHASE_BEGIN();
    if (F.bx == 0) {
        LAS int* sm = (LAS int*)F.lds;
        if (F.tid < 128) sm[F.tid] = (F.tid >= 32 && F.tid < 64) ? 0 : (F.tid == 97 ? (1 << 30) : -(1 << 30));
        if (F.tid < 256) sm[128 + F.tid] = -(1 << 30);
        __syncthreads();
        if (F.tid < 256) { const GAS unsigned long long* tr = TRACE_P + (size_t)F.tid * 128; const unsigned long long ref = TRACE_P[63 * 2] - 100000ull;
            for (int k = 0; k < 29; ++k) { const int a = (int)(tr[2 * k] - ref), lv = (int)(tr[2 * k + 1] - ref);
                __hip_atomic_fetch_max((int*)&sm[k], a, __ATOMIC_RELAXED, __HIP_MEMORY_SCOPE_WORKGROUP); __hip_atomic_fetch_add((int*)&sm[32 + k], a, __ATOMIC_RELAXED, __HIP_MEMORY_SCOPE_WORKGROUP);
                __hip_atomic_fetch_max((int*)&sm[64 + k], lv, __ATOMIC_RELAXED, __HIP_MEMORY_SCOPE_WORKGROUP); }
            for (int k = 0; k < 29; ++k) __hip_atomic_fetch_max((int*)&sm[128 + (F.tid & 7) * 32 + k], (int)(tr[2 * k] - ref), __ATOMIC_RELAXED, __HIP_MEMORY_SCOPE_WORKGROUP);
            const int st = (int)(tr[126] - ref); __hip_atomic_fetch_max((int*)&sm[96], st, __ATOMIC_RELAXED, __HIP_MEMORY_SCOPE_WORKGROUP); __hip_atomic_fetch_min((int*)&sm[97], st, __ATOMIC_RELAXED, __HIP_MEMORY_SCOPE_WORKGROUP); }
        __syncthreads();
        if (F.tid == 0) {
            const unsigned long long ref0 = TRACE_P[63 * 2] - 100000ull;
            float v[2];
            for (int c = 0; c < 2; ++c) { const int kind = c ? PROBE_K2 : PROBE_K1, mask = c ? PROBE_M2 : PROBE_M1; float acc = 0.f;
                for (int k = 0; k < 28; ++k) if ((mask >> (k % 7)) & 1) { const int prev = k ? sm[k - 1] : sm[96];
                    const float D = (float)(sm[k] - prev), I = (float)sm[k] - (float)sm[32 + k] * (1.0f / 256.0f), B = (float)(sm[64 + k] - sm[k]);
                    acc += kind == 0 ? D : kind == 1 ? I : kind == 2 ? B : 0.f; }
                if (kind == 3) acc = (float)(sm[28] - sm[97]);
                if (kind == 4) acc = (float)(sm[28] - sm[27]);
                if (kind == 5) acc = (float)(sm[96] - sm[97]);
                if (kind == 8) for (int l = 0; l < 4; ++l) acc += (float)((int)(pg8::g_tu[59 * l + (mask & 255)] - ref0) - (int)(pg8::g_tu[59 * l + ((mask >> 8) & 255)] - ref0));
                if (kind == 9) for (int l = 0; l < 4; ++l) acc += (float)((int)(pg8::g_tu[59 * l + (mask & 255)] - ref0) - (int)(TRACE_P[(7 * l + ((mask >> 8) & 255)) * 2 + 1] - ref0));
                if (kind == 10) { float dc = 0.f, dt = 0.f; for (int l = 0; l < 4; ++l) { const int k = 7 * l + mask; if (k == 0) continue;
                        dc += (float)(long long)(TRACE_P[(32 + k) * 2] - TRACE_P[(32 + k - 1) * 2 + 1]); dt += (float)(long long)(TRACE_P[k * 2] - TRACE_P[(k - 1) * 2 + 1]); }
                    acc = dc / dt * 100.0f * 100.0f; }
                if (kind == 11) for (int l = 0; l < 4; ++l) { float summax = 0.f, maxsum = 0.f;
                        for (int k = 7 * l + 1; k < 7 * l + 7; ++k) summax += (float)(sm[k] - sm[64 + k - 1]);
                        for (int g = 0; g < 8; ++g) { float sg = 0.f; for (int k = 7 * l + 1; k < 7 * l + 7; ++k) sg += (float)(sm[128 + g * 32 + k] - sm[64 + k - 1]); maxsum = sg > maxsum ? sg : maxsum; }
                        acc += summax - maxsum; }
                if (kind == 12) for (int l = 0; l < 4; ++l) acc += (float)((int)(pg8::g_tu[256 + l * 4 + mask] - ref0) - (int)(TRACE_P[(7 * l + 1) * 2 + 1] - ref0));
                if (kind == 6) acc = (float)(sm[mask] - (mask ? sm[mask - 1] : sm[96]));
                if (kind == 7) acc = (float)sm[mask] - (float)sm[32 + mask] * (1.0f / 256.0f);
                v[c] = acc * 0.01f; }
            const unsigned long long tend = rt() + (unsigned long long)(v[0] * 100.0f * (float)PROBE_MULT);
            while (rt() < tend) __builtin_amdgcn_s_sleep(8); }
    }
#endif
}

extern "C" void kernel_launch(void* const* d_in, const int* in_sizes, int n_in, void* d_out, int out_size, void* d_ws, size_t ws_size, hipStream_t stream) {
    static int grid = 0;
    if (grid == 0) {
        if (n_in != 20 || in_sizes[0] != T * DM || out_size != T * DM || ws_size < WS_END) { fprintf(stderr, "kernel_launch: unexpected shapes (n_in %d, in0 %d, out %d, ws %zu); nothing launched\n", n_in, n_in > 0 ? in_sizes[0] : -1, out_size, ws_size); grid = -1; return; }
        int dev = 0, cus = 0, per_cu = 0;
        if (hipGetDevice(&dev) != hipSuccess || hipDeviceGetAttribute(&cus, hipDeviceAttributeMultiprocessorCount, dev) != hipSuccess) { grid = -1; return; }
        if (hipFuncSetAttribute((const void*)mk_fwd, hipFuncAttributeMaxDynamicSharedMemorySize, LDS_BYTES) != hipSuccess) { fprintf(stderr, "kernel_launch: hipFuncSetAttribute failed\n"); grid = -1; return; }
        if (hipOccupancyMaxActiveBlocksPerMultiprocessor(&per_cu, (const void*)mk_fwd, NWAVES * 64, LDS_BYTES) != hipSuccess || per_cu < 1) fprintf(stderr, "kernel_launch: occupancy query reports %d\n", per_cu);
        (void)hipGetLastError();
        grid = cus;
    }
    if (grid < 0) return;
    if (hipMemsetAsync((char*)d_ws + WS_CTL, 0, CTL_ZERO_BYTES, stream) != hipSuccess) return;
    Args a{};
    for (int i = 0; i < 20; ++i) a.in[i] = (const float*)d_in[i];
    a.out = (float*)d_out; a.ws = (unsigned char*)d_ws;
    hipLaunchKernelGGL(mk_fwd, dim3(grid), dim3(NWAVES * 64), LDS_BYTES, stream, a);
    const hipError_t le = hipPeekAtLastError();
    if (le != hipSuccess) fprintf(stderr, "kernel_launch: launch failed: %s\n", hipGetErrorName(le));
}
```

```cpp
#include <hip/hip_runtime.h>
#include <cstdio>
#include <cstdint>
#ifndef REP_PA
#define REP_PA 1
#endif
#ifndef REP_PB
#define REP_PB 1
#endif
#ifndef REP_PC
#define REP_PC 1
#endif
#ifndef REP_PD
#define REP_PD 1
#endif
#ifndef REP_PE
#define REP_PE 1
#endif
#ifndef REP_PF
#define REP_PF 1
#endif
#ifndef REP_PG
#define REP_PG 1
#endif
#ifndef REP_PH
#define REP_PH 1
#endif
#ifndef PROBE_EPI2_Z
#define PROBE_EPI2_Z false
#endif
#ifndef PROBE_EPI2_U
#define PROBE_EPI2_U false
#endif
#ifndef EPI_NT
#define EPI_NT 1
#endif
#if EPI_NT
#define EPI_STREAM_STORE(p, v) __builtin_nontemporal_store((v), (p))
#else
#define EPI_STREAM_STORE(p, v) (*(p) = (v))
#endif
#ifndef PH_A_AUX
#define PH_A_AUX 0
#endif
#ifndef ATT_STATIC_PRIO
#define ATT_STATIC_PRIO 0
#endif
#ifndef GEMM_WGM
#define GEMM_WGM 4
#endif
#ifndef PH_WGM
#define PH_WGM 4
#endif
#ifndef PD_WGM
#define PD_WGM 4
#endif
#ifndef PB_F8_WGM
#define PB_F8_WGM 8
#endif
#ifndef PB_BF_WGM
#define PB_BF_WGM 8
#endif
#ifndef PD_STAGGER_SHIFT
#define PD_STAGGER_SHIFT 0
#endif
#ifndef PD_STAGGER_TICKS
#define PD_STAGGER_TICKS 0
#endif
#ifndef PROBE_QOB
#define PROBE_QOB 0
#endif
#ifndef PROBE_QOA
#define PROBE_QOA 0
#endif
#ifndef PROBE_QOC
#define PROBE_QOC 0
#endif
#ifndef XVAR_DIFF
#define XVAR_DIFF 0
#endif
#ifndef XREP_DIFF
#define XREP_DIFF 0
#endif
#ifndef XREP_SWA
#define XREP_SWA 0
#endif
#ifndef XREP_MEM
#define XREP_MEM 0
#endif
#ifndef MFMA_DIFF
#define MFMA_DIFF 1
#endif
#ifndef MFMA_SWA
#define MFMA_SWA 1
#endif
#ifndef MFMA_MEM
#define MFMA_MEM 1
#endif

namespace pg8 {
#define PG8_LAS __attribute__((address_space(3)))
typedef unsigned short bf16_t;
typedef short bf16x8 __attribute__((ext_vector_type(8)));
typedef float f32x4 __attribute__((ext_vector_type(4)));
typedef unsigned u32x4 __attribute__((ext_vector_type(4)));
constexpr int BM = 256, BK = 64, HALF = 128, HTB = HALF * BK * 2  , STAGE_BYTES = 8 * HTB, NXCD = 8, WGM = 8;

__host__ __device__ __forceinline__ int lds_byte(int r, int c) { const int st = (r >> 4) * 2 + (c >> 5), rr = r & 15, cc = c & 31, ob = rr * 64 + cc * 2; return st * 1024 + (ob ^ (((ob >> 9) & 1) << 5)); }
__host__ __device__ __forceinline__ void stage_rc(int b, int& R, int& C) { const int st = b / 1024, sb = b % 1024, swz = sb ^ (((sb >> 9) & 1) << 5); R = (st >> 1) * 16 + swz / 64; C = (st & 1) * 32 + (swz % 64) / 2; }
__host__ __device__ __forceinline__ int perm32(int rho) { const int n = rho >> 4, i = rho & 15; return 8 * (i >> 2) + 4 * n + (i & 3); }

struct Unit { int pm, pn, br; };
struct Gemm { const bf16_t* A; const bf16_t* Bt; int K, lda, ldb; long a_br1, a_br2, b_br; long kstepA, tstepA; int pmul;
    __device__ __forceinline__ long aoff(int br) const { return br == 0 ? 0l : (br == 1 ? a_br1 : a_br2); } };

struct StaticOrder {
    int nM, nN, nwg, G, c, wgm;
    __host__ __device__ void init(int M, int N, int G_, int c_, int wgm_ = WGM) { nM = M / BM; nN = N / BM; nwg = nM * nN; G = G_; c = c_; wgm = wgm_; }
    __host__ __device__ bool tile(long L, Unit& u) const {
        if (L >= nwg) return false;
        int wgid = (int)L; { const int q = nwg / NXCD, r = nwg % NXCD, xcd = wgid % NXCD, off = wgid / NXCD; wgid = (xcd < r ? xcd * (q + 1) : r * (q + 1) + (xcd - r) * q) + off; }
        const int nig = wgm * nN, gid = wgid / nig, fm = gid * wgm, gsz = (nM - fm) < wgm ? (nM - fm) : wgm;
        u.pm = fm + ((wgid % nig) % gsz); u.pn = (wgid % nig) / gsz; u.br = 0; return true;
    }
    __host__ __device__ bool next(int i, Unit& u) const { return tile((long)i * G + c, u); }
    __device__ __forceinline__ void a_ready(const Unit&) const {}
    __device__ __forceinline__ void done(const Unit&) const {}
};
struct TwoGemmOrder : StaticOrder {
    int nM2, nwg2;
    __host__ __device__ void init2(int M2, int N2) { nM2 = M2 / BM; nwg2 = nM2 * (N2 / BM); }
    __host__ __device__ bool next(int i, Unit& u) const { const long L = (long)i * G + c; if (L < nwg) return tile(L, u); const int t = (int)(L - nwg); if (t >= nwg2) return false; u.pm = t % nM2; u.pn = t / nM2; u.br = 1; return true; }
};
template <int NBR> struct BranchOrder : StaticOrder {
    __host__ __device__ bool next(int i, Unit& u) const { const int t = i / NBR; if (!tile((long)t * G + c, u)) return false; u.br = i - t * NBR; return true; }
};

__device__ __forceinline__ unsigned cvt_pk_bf16(float lo, float hi) { unsigned r; asm volatile("v_cvt_pk_bf16_f32 %0, %1, %2" : "=v"(r) : "v"(lo), "v"(hi)); return r; }
__device__ __forceinline__ float bf_lo(unsigned w) { return __uint_as_float(w << 16); }
__device__ __forceinline__ float bf_hi(unsigned w) { return __uint_as_float(w & 0xffff0000u); }


struct EpiZ {
    static constexpr bool PERM = true, AFTER_DRAIN = false, PROBE2 = PROBE_EPI2_Z;
    int pn_split, pn_jump, pn_qa; float ascale3;
    bf16_t* O; int ldc; const float* bgate; int gate_pn0; bf16_t* O2; int ldc2; float ascale; const float* rs; float ascale2;
    __device__ __forceinline__ void operator()(const f32x4 (&acc)[2][2][4][2], const Unit& u, int wr, int wc, int fr_in, int fq_in) const {
        int fr = fr_in, fq = fq_in; asm volatile("" : "+v"(fr), "+v"(fq));
        const int row0 = u.pm * BM + wr * 64 + fr; const int col0 = (u.pn + ((u.pn >= pn_split && u.br == 0) ? pn_jump : 0)) * BM + wc * 32 + 8 * fq;
        const bool gate = u.pn >= gate_pn0 && u.br == 0;
        float a1_ = ascale, a2_ = ascale2, a3_ = ascale3; asm volatile("" : "+s"(a1_), "+s"(a2_), "+s"(a3_));
        const float asc = gate ? a1_ : ((u.pn < pn_qa && u.br == 0) ? a3_ : ((u.pn >= pn_split && u.br == 0) ? a2_ : a1_));
        const __attribute__((address_space(1))) float* bg = (const __attribute__((address_space(1))) float*)bgate; asm volatile("" : "+s"(bg));
        const int bcol = (gate ? (u.pn - gate_pn0) * BM : 0) + wc * 32 + 8 * fq; const float gsel = gate ? 1.f : 0.f;
        const __attribute__((address_space(1))) float* rsp = (const __attribute__((address_space(1))) float*)rs; asm volatile("" : "+s"(rsp));
        float rsr[2][4]; const float rsel = u.br ? 0.f : 1.f;
#pragma unroll
        for (int ai = 0; ai < 2; ++ai)
#pragma unroll
            for (int m = 0; m < 4; ++m) { const float r = rsp[row0 + ai * HALF + m * 16]; rsr[ai][m] = ((r - 1.0f) * rsel + 1.0f) * asc; }
        f32x4 bv[2][2];
#pragma unroll
        for (int bj = 0; bj < 2; ++bj)
#pragma unroll
            for (int n = 0; n < 2; ++n) bv[bj][n] = *(const __attribute__((address_space(1))) f32x4*)(bg + bcol + bj * HALF + 4 * n) * gsel;
#pragma unroll
        for (int ai = 0; ai < 2; ++ai)
#pragma unroll
            for (int m = 0; m < 4; ++m) { bf16_t* rowp = (u.br ? O2 : O) + (size_t)(row0 + ai * HALF + m * 16) * (u.br ? ldc2 : ldc) + col0;
#pragma unroll
                for (int bj = 0; bj < 2; ++bj) { f32x4 v0 = acc[ai][bj][m][0] * rsr[ai][m] + bv[bj][0], v1 = acc[ai][bj][m][1] * rsr[ai][m] + bv[bj][1];
#if defined(PROBE_QQKV)
                    if (!gate && u.br == 0) {
#pragma unroll
                        for (int j = 0; j < 4; ++j) { v0[j] = __uint_as_float((__float_as_uint(v0[j]) + (0x00400000u >> PROBE_QQKV)) & ~((0x00800000u >> PROBE_QQKV) - 1u)); v1[j] = __uint_as_float((__float_as_uint(v1[j]) + (0x00400000u >> PROBE_QQKV)) & ~((0x00800000u >> PROBE_QQKV) - 1u)); } }
#endif
                    if (gate) {
#if defined(PROBE_QGATE)
#pragma unroll
                        for (int j = 0; j < 4; ++j) { v0[j] = __uint_as_float((__float_as_uint(v0[j]) + (0x00400000u >> PROBE_QGATE)) & ~((0x00800000u >> PROBE_QGATE) - 1u)); v1[j] = __uint_as_float((__float_as_uint(v1[j]) + (0x00400000u >> PROBE_QGATE)) & ~((0x00800000u >> PROBE_QGATE) - 1u)); }
#endif
#pragma unroll
                        for (int j = 0; j < 4; ++j) { v0[j] = __builtin_amdgcn_rcpf(1.0f + __builtin_amdgcn_exp2f(-1.4426950408889634f * v0[j])); v1[j] = __builtin_amdgcn_rcpf(1.0f + __builtin_amdgcn_exp2f(-1.4426950408889634f * v1[j])); }
                    }
                    u32x4 w; w.x = cvt_pk_bf16(v0[0], v0[1]); w.y = cvt_pk_bf16(v0[2], v0[3]); w.z = cvt_pk_bf16(v1[0], v1[1]); w.w = cvt_pk_bf16(v1[2], v1[3]);
                    EPI_STREAM_STORE((u32x4*)(rowp + bj * HALF), w); } }
    }
};
template <int ACT> struct EpiBf16 {
    static constexpr bool PERM = true, AFTER_DRAIN = false, PROBE2 = false;
    bf16_t* O; int ldc;
    __device__ __forceinline__ void operator()(const f32x4 (&acc)[2][2][4][2], const Unit& u, int wr, int wc, int fr_in, int fq_in) const {
        int fr = fr_in, fq = fq_in; asm volatile("" : "+v"(fr), "+v"(fq));
        const int row0 = u.pm * BM + wr * 64 + fr; const int col0 = u.pn * BM + wc * 32 + 8 * fq;
#pragma unroll
        for (int ai = 0; ai < 2; ++ai)
#pragma unroll
            for (int m = 0; m < 4; ++m) { bf16_t* rowp = O + (size_t)(row0 + ai * HALF + m * 16) * ldc + col0;
#pragma unroll
                for (int bj = 0; bj < 2; ++bj) { f32x4 v0 = acc[ai][bj][m][0], v1 = acc[ai][bj][m][1];
                    if (ACT == 1) {
#pragma unroll
                        for (int j = 0; j < 4; ++j) { const float a = fmaxf(v0[j], 0.f), b = fmaxf(v1[j], 0.f); v0[j] = a * a; v1[j] = b * b; } }
                    u32x4 w; w.x = cvt_pk_bf16(v0[0], v0[1]); w.y = cvt_pk_bf16(v0[2], v0[3]); w.z = cvt_pk_bf16(v1[0], v1[1]); w.w = cvt_pk_bf16(v1[2], v1[3]);
                    *(u32x4*)(rowp + bj * HALF) = w; } }
    }
};
struct EpiUTiled {
    static constexpr bool PERM = true, AFTER_DRAIN = false, PROBE2 = PROBE_EPI2_U;
    bf16_t* O; int nkt;
    __device__ __forceinline__ void operator()(const f32x4 (&acc)[2][2][4][2], const Unit& u, int wr, int wc, int fr_in, int fq_in) const {
        int fr = fr_in, fq = fq_in; asm volatile("" : "+v"(fr), "+v"(fq));
        const int r0 = wr * 64 + fr;
#pragma unroll
        for (int ai = 0; ai < 2; ++ai)
#pragma unroll
            for (int m = 0; m < 4; ++m) { const int r = r0 + ai * HALF + m * 16;
#pragma unroll
                for (int bj = 0; bj < 2; ++bj) { f32x4 v0 = acc[ai][bj][m][0], v1 = acc[ai][bj][m][1];
#pragma unroll
                    for (int j = 0; j < 4; ++j) { const float a = fmaxf(v0[j], 0.f), b = fmaxf(v1[j], 0.f); v0[j] = a * a; v1[j] = b * b; }
                    u32x4 w; w.x = cvt_pk_bf16(v0[0], v0[1]); w.y = cvt_pk_bf16(v0[2], v0[3]); w.z = cvt_pk_bf16(v1[0], v1[1]); w.w = cvt_pk_bf16(v1[2], v1[3]);
                    const int kt = u.pn * 4 + bj * 2 + (wc >> 1), c = (wc & 1) * 32 + 8 * fq;
                    EPI_STREAM_STORE((u32x4*)(O + (((size_t)u.pm * nkt + kt) * 256 + r) * 64 + c), w); } }
    }
};
struct EpiBranch {
    static constexpr bool PERM = true, AFTER_DRAIN = false, PROBE2 = false;
    bf16_t* mrg; int ldm; const bf16_t* gates; int ldg; int gate_br; int gidx0, gstep, first0; float ascale;
    __device__ __forceinline__ void operator()(const f32x4 (&acc)[2][2][4][2], const Unit& u, int wr, int wc, int fr_in, int fq_in) const {
        int fr = fr_in, fq = fq_in; asm volatile("" : "+v"(fr), "+v"(fq));
        const int row0 = u.pm * BM + wr * 64 + fr; const int col0 = u.pn * BM + wc * 32 + 8 * fq;
        const int brx = gidx0 + u.br * gstep; const bool first = (first0 != 0) && (u.br == 0);
#pragma unroll
        for (int ai = 0; ai < 2; ++ai) {
            u32x4 g[4][2], p[4][2];
#pragma unroll
            for (int m = 0; m < 4; ++m) { const size_t row = (size_t)(row0 + ai * HALF + m * 16);
                const bf16_t* gp = gates + row * ldg + (size_t)brx * gate_br + col0; const bf16_t* mp = mrg + row * ldm + col0;
#pragma unroll
                for (int bj = 0; bj < 2; ++bj) { g[m][bj] = *(const u32x4*)(gp + bj * HALF); p[m][bj] = (u32x4){0u, 0u, 0u, 0u}; if (!first) p[m][bj] = *(const u32x4*)(mp + bj * HALF); } }
            asm volatile("" ::: "memory");
#pragma unroll
            for (int m = 0; m < 4; ++m) { bf16_t* mp = mrg + (size_t)(row0 + ai * HALF + m * 16) * ldm + col0;
#pragma unroll
                for (int bj = 0; bj < 2; ++bj) { const u32x4 gg = g[m][bj], pp = p[m][bj]; const f32x4 a0 = acc[ai][bj][m][0] * ascale, a1 = acc[ai][bj][m][1] * ascale;
                    u32x4 w;
                    w.x = cvt_pk_bf16(bf_lo(pp.x) + bf_lo(gg.x) * a0[0], bf_hi(pp.x) + bf_hi(gg.x) * a0[1]);
                    w.y = cvt_pk_bf16(bf_lo(pp.y) + bf_lo(gg.y) * a0[2], bf_hi(pp.y) + bf_hi(gg.y) * a0[3]);
                    w.z = cvt_pk_bf16(bf_lo(pp.z) + bf_lo(gg.z) * a1[0], bf_hi(pp.z) + bf_hi(gg.z) * a1[1]);
                    w.w = cvt_pk_bf16(bf_lo(pp.w) + bf_lo(gg.w) * a1[2], bf_hi(pp.w) + bf_hi(gg.w) * a1[3]);
                    *(u32x4*)(mp + bj * HALF) = w; } }
            asm volatile("" ::: "memory");
        }
    }
};
template <bool W8, bool RS> struct EpiResB {
    static constexpr bool PERM = true, AFTER_DRAIN = false, PROBE2 = false;
    bf16_t* x; int ldx; float* ss; unsigned char* x8; int ld8; const float* rs;
    __device__ __forceinline__ void operator()(const f32x4 (&acc)[2][2][4][2], const Unit& u, int wr, int wc, int fr_in, int fq_in) const {
        int fr = fr_in, fq = fq_in; asm volatile("" : "+v"(fr), "+v"(fq));
        const int row0 = u.pm * BM + wr * 64 + fr, col0 = u.pn * BM + wc * 32 + 8 * fq;
#pragma unroll
        for (int ai = 0; ai < 2; ++ai) {
            u32x4 p[4][2];
            float rq[4];
#pragma unroll
            for (int m = 0; m < 4; ++m) { rq[m] = 1.0f; if constexpr (RS) { const float r_ = rs[row0 + ai * HALF + m * 16]; rq[m] = r_ * r_; } }
#pragma unroll
            for (int m = 0; m < 4; ++m) { const bf16_t* xp = x + (size_t)(row0 + ai * HALF + m * 16) * ldx + col0;
#pragma unroll
                for (int bj = 0; bj < 2; ++bj) p[m][bj] = *(const u32x4*)(xp + bj * HALF); }
            asm volatile("" ::: "memory");
#pragma unroll
            for (int m = 0; m < 4; ++m) { const int row = row0 + ai * HALF + m * 16; bf16_t* xp = x + (size_t)row * ldx + col0; float s = 0.f;
#pragma unroll
                for (int bj = 0; bj < 2; ++bj) { const u32x4 pp = p[m][bj];
                    f32x4 a0 = acc[ai][bj][m][0], a1 = acc[ai][bj][m][1]; if constexpr (RS) { a0 = a0 * rq[m]; a1 = a1 * rq[m]; }
                    const float v0 = bf_lo(pp.x) + a0[0], v1 = bf_hi(pp.x) + a0[1], v2 = bf_lo(pp.y) + a0[2], v3 = bf_hi(pp.y) + a0[3], v4 = bf_lo(pp.z) + a1[0], v5 = bf_hi(pp.z) + a1[1], v6 = bf_lo(pp.w) + a1[2], v7 = bf_hi(pp.w) + a1[3];
                    s += ((v0 * v0 + v1 * v1) + (v2 * v2 + v3 * v3)) + ((v4 * v4 + v5 * v5) + (v6 * v6 + v7 * v7));
                    u32x4 w; w.x = cvt_pk_bf16(v0, v1); w.y = cvt_pk_bf16(v2, v3); w.z = cvt_pk_bf16(v4, v5); w.w = cvt_pk_bf16(v6, v7);
                    *(u32x4*)(xp + bj * HALF) = w;
                    if constexpr (W8) { typedef unsigned u32x2_ __attribute__((ext_vector_type(2))); u32x2_ q; int t0 = 0, t1 = 0;
                        t0 = __builtin_amdgcn_cvt_pk_fp8_f32(v0, v1, t0, false); t0 = __builtin_amdgcn_cvt_pk_fp8_f32(v2, v3, t0, true); t1 = __builtin_amdgcn_cvt_pk_fp8_f32(v4, v5, t1, false); t1 = __builtin_amdgcn_cvt_pk_fp8_f32(v6, v7, t1, true);
                        q.x = (unsigned)t0; q.y = (unsigned)t1; *(u32x2_*)(x8 + (size_t)row * ld8 + col0 + bj * HALF) = q; } }
                s += __shfl_xor(s, 16); s += __shfl_xor(s, 32);
                if (fq == 0) ss[(size_t)row * 32 + u.pn * 4 + wc] = s; }
            asm volatile("" ::: "memory");
        }
    }
};
struct EpiRes {
    static constexpr bool PERM = false, AFTER_DRAIN = false, PROBE2 = false;
    const float* xin; float* xout; int ldc;
    __device__ __forceinline__ void operator()(const f32x4 (&acc)[2][2][4][2], const Unit& u, int wr, int wc, int fr_in, int fq_in) const {
        int fr = fr_in, fq = fq_in; asm volatile("" : "+v"(fr), "+v"(fq));
        const int row0 = u.pm * BM + wr * 64 + fr, col0 = u.pn * BM + wc * 32 + 4 * fq;
#pragma unroll
        for (int ai = 0; ai < 2; ++ai)
#pragma unroll
            for (int m = 0; m < 4; ++m) { const size_t off = (size_t)(row0 + ai * HALF + m * 16) * ldc + col0;
#pragma unroll
                for (int bj = 0; bj < 2; ++bj)
#pragma unroll
                    for (int n = 0; n < 2; ++n) { const f32x4 b = *(const f32x4*)(xin + off + bj * HALF + n * 16); *(f32x4*)(xout + off + bj * HALF + n * 16) = b + acc[ai][bj][m][n]; } }
    }
};
#if defined(PROBE_TRACE)
__device__ volatile unsigned long long g_tu[512]; __device__ volatile int g_tn;
#define PG8_TRACE_UNIT() do { if (blockIdx.x == 0 && threadIdx.x == 0) { const int n_ = g_tn; g_tu[n_ & 511] = __builtin_amdgcn_s_memrealtime(); g_tn = n_ + 1; } } while (0)
#else
#define PG8_TRACE_UNIT() do { } while (0)
#endif
typedef int pg8_v8i __attribute__((ext_vector_type(8))); typedef int pg8_v4i __attribute__((ext_vector_type(4)));
__device__ __forceinline__ pg8_v8i pg8_cat(bf16x8 lo, bf16x8 hi) { const pg8_v4i a = __builtin_bit_cast(pg8_v4i, lo), b = __builtin_bit_cast(pg8_v4i, hi); return (pg8_v8i){a.x, a.y, a.z, a.w, b.x, b.y, b.z, b.w}; }
template <class Epi, class Sched, bool ALIGN_EPI = false, bool SP2 = false, bool F8 = false, int A_AUX = 0>
__device__ __forceinline__ void gemm_phase(PG8_LAS unsigned char* lds, const Gemm g, const Sched& S, const Epi& E, const int tid) {
    const int wid = __builtin_amdgcn_readfirstlane(tid >> 6), lane = tid & 63, wr = wid >> 2, wc = wid & 3, fr = lane & 15, fq = lane >> 4;
    const int K = g.K, nt = K / BK;
    unsigned voffA[2], voffB[2];
#pragma unroll
    for (int i = 0; i < 2; ++i) { int R, C; stage_rc(tid * 16 + i * 8192, R, C); const int Rb = Epi::PERM ? ((R & ~31) + perm32(R & 31)) : R;
        voffA[i] = (unsigned)(R * g.lda + C) * 2u; voffB[i] = (unsigned)(Rb * g.ldb + C) * 2u; }
    const size_t kstep = (size_t)(BK * 2);
    const size_t kstepA = g.kstepA ? (size_t)g.kstepA : kstep;
    const size_t hstepA = (size_t)HALF * g.lda * 2, hstepB = (size_t)HALF * g.ldb * 2;
    const size_t tstepA = g.tstepA ? (size_t)g.tstepA : 2 * hstepA, tstepB = 2 * hstepB;
    const unsigned ldsw = (unsigned)wid * 1024u;
    const int aoff = lds_byte(wr * 64 + fr, fq * 8), boff = lds_byte(wc * 32 + fr, fq * 8);
#define PG8_SA(b, h) (((b) * 2 + (h)) * HTB)
#define PG8_SB(b, h) ((4 + (b) * 2 + (h)) * HTB)
#define PG8_STAGE(bufoff, gbase, voff) do { _Pragma("unroll") for (int _i = 0; _i < 2; ++_i) \
        __builtin_amdgcn_global_load_lds((const unsigned*)((const char*)(gbase) + (voff)[_i]), (PG8_LAS unsigned*)(lds + (bufoff) + ldsw + _i * 8192), 16, 0, ((bufoff) < 4 * HTB ? A_AUX : 0)); } while (0)
#define PG8_LDA(dst, b, h) do { _Pragma("unroll") for (int m = 0; m < 4; ++m) _Pragma("unroll") for (int k = 0; k < 2; ++k) dst[m][k] = *(const PG8_LAS bf16x8*)(lds + PG8_SA(b, h) + aoff + m * 2048 + k * 1024); } while (0)
#define PG8_LDB(dst, b, h) do { _Pragma("unroll") for (int n = 0; n < 2; ++n) _Pragma("unroll") for (int k = 0; k < 2; ++k) dst[n][k] = *(const PG8_LAS bf16x8*)(lds + PG8_SB(b, h) + boff + n * 2048 + k * 1024); } while (0)
#define PG8_MMA(ai, bj, At, Bt) do { __builtin_amdgcn_s_setprio(1); _Pragma("unroll") for (int m = 0; m < 4; ++m) _Pragma("unroll") for (int n = 0; n < 2; ++n) { \
        if constexpr (F8) { const pg8_v8i b8_ = pg8_cat(Bt[n][0], Bt[n][1]), a8_ = pg8_cat(At[m][0], At[m][1]); asm volatile("v_mfma_f32_16x16x128_f8f6f4 %0, %1, %2, %0" : "+v"(acc[ai][bj][m][n]) : "v"(b8_), "v"(a8_)); } \
        else { _Pragma("unroll") for (int k = 0; k < 2; ++k) acc[ai][bj][m][n] = __builtin_amdgcn_mfma_f32_16x16x32_bf16(Bt[n][k], At[m][k], acc[ai][bj][m][n], 0, 0, 0); } } __builtin_amdgcn_s_setprio(0); } while (0)
#define PG8_WAIT_V(n) asm volatile("s_waitcnt vmcnt(" #n ")" ::: "memory")
#define PG8_WAIT_L(n) asm volatile("s_waitcnt lgkmcnt(" #n ")" ::: "memory")
#define PG8_BAR __builtin_amdgcn_s_barrier()
#define PG8_SCHED __builtin_amdgcn_sched_barrier(0)
    __builtin_amdgcn_s_waitcnt(0);
    Unit cur, nxt; int ui = 0;
    if (!S.next(0, cur)) return;
    f32x4 acc[2][2][4][2];
#pragma unroll
    for (int a = 0; a < 2; ++a)
#pragma unroll
        for (int b = 0; b < 2; ++b)
#pragma unroll
            for (int m = 0; m < 4; ++m)
#pragma unroll
                for (int n = 0; n < 2; ++n) acc[a][b][m][n] = (f32x4){0.f, 0.f, 0.f, 0.f};
    bf16x8 At[4][2], B0[2][2], B1[2][2];
    const char* cA = (const char*)g.A + (size_t)(cur.pm * g.pmul) * tstepA + g.aoff(cur.br); const char* cB = (const char*)g.Bt + (size_t)(cur.pn * g.pmul) * tstepB + (long)cur.br * g.b_br;
    S.a_ready(cur);
    if constexpr (SP2) {
        PG8_STAGE(PG8_SB(0, 0), cB, voffB); PG8_STAGE(PG8_SB(0, 1), cB + hstepB, voffB); PG8_STAGE(PG8_SA(0, 0), cA, voffA); PG8_STAGE(PG8_SA(0, 1), cA + hstepA, voffA);
        if (wr == 1) PG8_BAR;
        PG8_WAIT_V(2); PG8_BAR;
        PG8_STAGE(PG8_SB(1, 0), cB + kstep, voffB); PG8_STAGE(PG8_SA(1, 0), cA + kstepA, voffA); PG8_STAGE(PG8_SB(1, 1), cB + hstepB + kstep, voffB);
        PG8_WAIT_V(6); PG8_BAR;
    } else {
        PG8_STAGE(PG8_SB(0, 0), cB, voffB); PG8_STAGE(PG8_SA(0, 0), cA, voffA); PG8_STAGE(PG8_SB(0, 1), cB + hstepB, voffB); PG8_STAGE(PG8_SA(0, 1), cA + hstepA, voffA);
        if (wr == 1) PG8_BAR;
        PG8_WAIT_V(4); PG8_BAR;
        PG8_STAGE(PG8_SB(1, 0), cB + kstep, voffB); PG8_STAGE(PG8_SA(1, 0), cA + kstepA, voffA); PG8_STAGE(PG8_SB(1, 1), cB + hstepB + kstep, voffB);
        PG8_WAIT_V(6); PG8_BAR;
    }
    for (;;) {
        const bool has_next = S.next(ui + 1, nxt);
        const char* nA = has_next ? (const char*)g.A + (size_t)(nxt.pm * g.pmul) * tstepA + g.aoff(nxt.br) : cA; const char* nB = has_next ? (const char*)g.Bt + (size_t)(nxt.pn * g.pmul) * tstepB + (long)nxt.br * g.b_br : cB;
        for (int t = 0; t < nt; t += 2) {
            const bool last = (t == nt - 2);
            const char* a1 = cA + (size_t)(t + 1) * kstepA;
            const char* a2 = last ? nA : cA + (size_t)(t + 2) * kstepA; const char* b2 = last ? nB : cB + (size_t)(t + 2) * kstep;
            const char* a3 = a2 + kstepA; const char* b3 = b2 + kstep;
            if (last && has_next) S.a_ready(nxt);
            if constexpr (SP2) {
            PG8_LDB(B0, 0, 0); PG8_LDB(B1, 0, 1); PG8_SCHED; PG8_LDA(At, 0, 0); PG8_STAGE(PG8_SA(1, 1), a1 + hstepA, voffA);
            PG8_WAIT_V(8); PG8_WAIT_L(0); PG8_BAR; PG8_MMA(0, 0, At, B0); PG8_MMA(0, 1, At, B1); PG8_BAR; PG8_SCHED;
            PG8_LDA(At, 0, 1); PG8_STAGE(PG8_SB(0, 0), b2, voffB); PG8_STAGE(PG8_SB(0, 1), b2 + hstepB, voffB); PG8_STAGE(PG8_SA(0, 0), a2, voffA);
            PG8_WAIT_V(8); PG8_WAIT_L(0); PG8_BAR; PG8_MMA(1, 0, At, B0); PG8_MMA(1, 1, At, B1); PG8_BAR; PG8_SCHED;
            PG8_LDB(B0, 1, 0); PG8_LDB(B1, 1, 1); PG8_SCHED; PG8_LDA(At, 1, 0); PG8_STAGE(PG8_SA(0, 1), a2 + hstepA, voffA);
            PG8_WAIT_V(8); PG8_WAIT_L(0); PG8_BAR; PG8_MMA(0, 0, At, B0); PG8_MMA(0, 1, At, B1); PG8_BAR; PG8_SCHED;
            PG8_LDA(At, 1, 1); PG8_STAGE(PG8_SB(1, 0), b3, voffB); PG8_STAGE(PG8_SB(1, 1), b3 + hstepB, voffB); PG8_STAGE(PG8_SA(1, 0), a3, voffA);
            PG8_WAIT_V(8); PG8_WAIT_L(0); PG8_BAR; PG8_MMA(1, 0, At, B0); PG8_MMA(1, 1, At, B1); PG8_BAR; PG8_SCHED;
            } else {
            PG8_LDB(B0, 0, 0); PG8_SCHED; PG8_LDA(At, 0, 0); PG8_STAGE(PG8_SA(1, 1), a1 + hstepA, voffA);
            PG8_WAIT_L(8); PG8_BAR; PG8_WAIT_L(0); PG8_MMA(0, 0, At, B0); PG8_BAR; PG8_SCHED;
            PG8_LDB(B1, 0, 1); PG8_STAGE(PG8_SB(0, 0), b2, voffB);
            PG8_BAR; PG8_WAIT_L(0); PG8_MMA(0, 1, At, B1); PG8_BAR;
            PG8_LDA(At, 0, 1); PG8_STAGE(PG8_SA(0, 0), a2, voffA);
            PG8_BAR; PG8_WAIT_L(0); PG8_MMA(1, 0, At, B0); PG8_BAR; PG8_SCHED;
            PG8_STAGE(PG8_SB(0, 1), b2 + hstepB, voffB);
            PG8_WAIT_V(6); PG8_BAR; PG8_MMA(1, 1, At, B1); PG8_BAR;
            PG8_LDB(B0, 1, 0); PG8_SCHED; PG8_LDA(At, 1, 0); PG8_STAGE(PG8_SA(0, 1), a2 + hstepA, voffA);
            PG8_WAIT_L(8); PG8_BAR; PG8_WAIT_L(0); PG8_MMA(0, 0, At, B0); PG8_BAR; PG8_SCHED;
            PG8_LDB(B1, 1, 1); PG8_STAGE(PG8_SB(1, 0), b3, voffB);
            PG8_BAR; PG8_WAIT_L(0); PG8_MMA(0, 1, At, B1); PG8_BAR;
            PG8_LDA(At, 1, 1); PG8_STAGE(PG8_SA(1, 0), a3, voffA);
            PG8_BAR; PG8_WAIT_L(0); PG8_MMA(1, 0, At, B0); PG8_BAR; PG8_SCHED;
            PG8_STAGE(PG8_SB(1, 1), b3 + hstepB, voffB);
            PG8_WAIT_V(6); PG8_BAR; PG8_MMA(1, 1, At, B1); PG8_BAR;
            }
        }
        if constexpr (F8) asm volatile("s_nop 15\n\ts_nop 7" ::: "memory");
        if constexpr (ALIGN_EPI) { if (wr == 0) PG8_BAR; }
        if constexpr (!Epi::AFTER_DRAIN) { E(acc, cur, wr, wc, fr, fq);
#if defined(PROBE_EPI2)
            if constexpr (Epi::PROBE2) { asm volatile("" ::: "memory"); E(acc, cur, wr, wc, fr, fq); }
#endif
            S.done(cur); PG8_TRACE_UNIT(); }
        if (!has_next) break;
#pragma unroll
        for (int a = 0; a < 2; ++a)
#pragma unroll
            for (int b = 0; b < 2; ++b)
#pragma unroll
                for (int m = 0; m < 4; ++m)
#pragma unroll
                    for (int n = 0; n < 2; ++n) acc[a][b][m][n] = (f32x4){0.f, 0.f, 0.f, 0.f};
        cur = nxt; cA = nA; cB = nB; ++ui;
        if constexpr (ALIGN_EPI) { if (wr == 1) PG8_BAR; }
    }
    PG8_WAIT_V(0);
    __builtin_amdgcn_s_waitcnt(0);
    if constexpr (!ALIGN_EPI) { if (wr == 0) PG8_BAR; }
    PG8_BAR;
    if constexpr (Epi::AFTER_DRAIN) { E.fused(acc, cur, wr, wc, fr, fq, lds, wid, lane); S.done(cur); PG8_TRACE_UNIT(); }
#undef PG8_SA
#undef PG8_SB
#undef PG8_STAGE
#undef PG8_LDA
#undef PG8_LDB
#undef PG8_MMA
#undef PG8_WAIT_V
#undef PG8_WAIT_L
#undef PG8_BAR
#undef PG8_SCHED
}
}
#define GAS __attribute__((address_space(1)))
#define LAS __attribute__((address_space(3)))
typedef unsigned short bf16;
typedef unsigned v4u __attribute__((ext_vector_type(4)));
typedef float f32x4 __attribute__((ext_vector_type(4)));
typedef short bf16x8 __attribute__((ext_vector_type(8)));
typedef GAS unsigned gu32;
typedef GAS unsigned long long gu64;
#define RLX_AGENT __ATOMIC_RELAXED, __HIP_MEMORY_SCOPE_AGENT
#define LDS_WAIT() asm volatile("s_waitcnt lgkmcnt(0)" ::: "memory")
#define VM_WAIT() asm volatile("s_waitcnt vmcnt(0)" ::: "memory")
__device__ __forceinline__ unsigned long long rt() { return __builtin_amdgcn_s_memrealtime(); }
__device__ __forceinline__ unsigned f2bf(float f) { unsigned u = __builtin_bit_cast(unsigned, f); return (u + 0x7fffu + ((u >> 16) & 1u)) >> 16; }
__device__ __forceinline__ unsigned pk2(float lo, float hi) { return f2bf(lo) | (f2bf(hi) << 16); }

#define XB_TMO      128
#define XB_XCNT(j)  (256  + 64 * (j))
#define XB_XSUB(j)  (1280 + 64 * (j))
#define XB_XGEN(j)  (2304 + 64 * (j))
#define XB_TOP      3328
#define XB_TOPGEN   3392
#define XCD_BAR_WORDS 3456
#define XB_SPIN_CAP (1u << 18)

__device__ __forceinline__ unsigned xb_ld(unsigned* p)              { return __hip_atomic_load(p, __ATOMIC_RELAXED, __HIP_MEMORY_SCOPE_AGENT); }
__device__ __forceinline__ unsigned xb_add(unsigned* p, unsigned v) { return __hip_atomic_fetch_add(p, v, __ATOMIC_RELAXED, __HIP_MEMORY_SCOPE_AGENT); }
__device__ __forceinline__ unsigned xb_xcc_id() { return (unsigned)__builtin_amdgcn_s_getreg((3 << 11) | 20) & 0xFu; }
#define XB_SPIN(cond, bar) do { unsigned _sp = 0; while (cond) { __builtin_amdgcn_s_sleep(1); \
    if ((++_sp & 255u) == 0u) { if (xb_ld(&(bar)[XB_TMO])) break; if (_sp > XB_SPIN_CAP) { atomicAdd(&(bar)[XB_TMO], 1u); break; } } } } while (0)

struct XcdBarrier {
    unsigned* bar; unsigned x;
    volatile LAS unsigned* st;
};

__device__ __forceinline__ XcdBarrier xcd_barrier_post(unsigned* bar, volatile LAS unsigned* st) {
    XcdBarrier b; b.bar = bar; b.x = xb_xcc_id(); b.st = st;
    if (threadIdx.x == 0) (void)xb_add(&bar[XB_XCNT(b.x)], 1u);
    return b;
}
__device__ __forceinline__ void xcd_barrier_complete(unsigned* bar, unsigned x, unsigned& nloc, unsigned& nx) {
    const unsigned G = gridDim.x * gridDim.y * gridDim.z;
    unsigned sum, cnt, mine, sp = 0u;
    for (;;) {
        sum = 0u; cnt = 0u; mine = 0u;
#pragma unroll
        for (unsigned j = 0; j < 16; ++j) { const unsigned c = xb_ld(&bar[XB_XCNT(j)]); sum += c; cnt += (c > 0u) ? 1u : 0u; mine = (j == x) ? c : mine; }
        if (sum == G) break;
        __builtin_amdgcn_s_sleep(1);
        if ((++sp & 255u) == 0u) { if (xb_ld(&bar[XB_TMO])) break; if (sp > XB_SPIN_CAP) { atomicAdd(&bar[XB_TMO], 1u); break; } }
    }
    nloc = mine > 0u ? mine : 1u; nx = cnt > 0u ? cnt : 1u;
}

__device__ __forceinline__ void xcd_barrier(const XcdBarrier& b) {
    asm volatile("s_waitcnt vmcnt(0)" ::: "memory");
    __syncthreads();
    if (threadIdx.x == 0) {
        unsigned* bar = b.bar;
        __builtin_amdgcn_s_waitcnt(0);
        unsigned nloc = b.st[0], nx = b.st[1];
        if (nloc == 0u) { xcd_barrier_complete(bar, b.x, nloc, nx); b.st[0] = nloc; b.st[1] = nx; }
        const unsigned old = xb_add(&bar[XB_XSUB(b.x)], 1u);
        const unsigned gen = old / nloc;
        if (old + 1u == (gen + 1u) * nloc) {
            __builtin_amdgcn_fence(__ATOMIC_RELEASE, "agent");
            asm volatile("s_waitcnt vmcnt(0)" ::: "memory");
            const unsigned og = xb_add(&bar[XB_TOP], 1u);
            const unsigned tg = og / nx;
            if (og + 1u == (tg + 1u) * nx) xb_add(&bar[XB_TOPGEN], 1u);
            else XB_SPIN(xb_ld(&bar[XB_TOPGEN]) == tg, bar);
            __builtin_amdgcn_fence(__ATOMIC_ACQUIRE, "agent");
            xb_add(&bar[XB_XGEN(b.x)], 1u);
            asm volatile("s_waitcnt vmcnt(0)" ::: "memory");
        } else {
            XB_SPIN(xb_ld(&bar[XB_XGEN(b.x)]) == gen, bar);
            __builtin_amdgcn_fence(__ATOMIC_ACQUIRE, "agent");
            asm volatile("s_waitcnt vmcnt(0)" ::: "memory");
        }
    }
    __syncthreads();
}

constexpr int NWAVES = 8;
constexpr int BATCH = 16, SEQ = 2048, DM = 2048, DEPTH = 4, NMEM = 256;
constexpr int T = BATCH * SEQ, TM = BATCH * NMEM;
constexpr int DIN = 11520, DFF = 8192, BW = 1024;
constexpr int C_QA = 0, C_KA = 1024, C_VA = 1152, C_QB = 1280, C_KB = 2304, C_VB = 3328, C_QC = 4352, C_GATE = 5376;
constexpr float LOG2E = 1.4426950408889634f;
constexpr float QS_A = 0.125f * LOG2E, QS_C = 0.0625f * LOG2E;
constexpr float RMS_EPS = 1e-6f, SUBLN_EPS = 1e-5f;

constexpr size_t MiB = 1u << 20;
constexpr size_t WS_CTL = 0, CTL_ZERO_BYTES = 1 * MiB;
constexpr size_t WS_TAB = 1 * MiB;
constexpr int KPAD = 64;
constexpr int LDH = DM + KPAD, LDU = DFF + KPAD, LDB = BW + KPAD;
constexpr size_t WS_WIN = 2 * MiB, WS_WMEM = 49 * MiB, WS_WBR = 58 * MiB, WS_WOUT = 71 * MiB, WS_W1 = 80 * MiB, WS_W2 = 114 * MiB;
constexpr size_t WS_Z = 148 * MiB;
constexpr size_t WS_H = 868 * MiB;
constexpr size_t WS_HM = 1004 * MiB;
constexpr size_t WS_MKV = 1022 * MiB;
constexpr int LD8 = DM + 128;
constexpr size_t WS_W8 = WS_WIN + 24 * MiB;
constexpr size_t WS_H8 = 1038 * MiB;
constexpr size_t WS_X = 1108 * MiB;
constexpr size_t WS_SS = 1242 * MiB;
constexpr size_t WS_RS1 = 1246 * MiB, WS_RS2 = 1247 * MiB;
constexpr size_t WS_STASH = 1248 * MiB;
constexpr int LDC8 = BW + 128;
constexpr size_t WS_OC8 = 1280 * MiB, WS_WBR8 = 1317 * MiB;
constexpr float OC8_SCALE = 8.0f;
constexpr size_t WS_OA8 = 1320 * MiB, WS_WBR8A = 1357 * MiB;
constexpr size_t WS_END = 1360 * MiB;
constexpr int N8_SWA = C_QB;
constexpr float W8_SCALE = 32.0f;
static_assert(WS_WIN + (size_t)DIN * LDH * 2 <= WS_WMEM && WS_WMEM + (size_t)2048 * LDH * 2 <= WS_WBR && WS_WBR + (size_t)3 * DM * LDB * 2 <= WS_WOUT && WS_WOUT + (size_t)DM * LDH * 2 <= WS_W1 &&
              WS_W1 + (size_t)DFF * LDH * 2 <= WS_W2 && WS_W2 + (size_t)DM * LDU * 2 <= WS_Z && WS_Z + (size_t)T * DIN * 2 <= WS_H && WS_Z + (size_t)T * LDU * 2 <= WS_H && WS_H + (size_t)T * LDH * 2 <= WS_HM &&
              WS_HM + (size_t)TM * LDH * 2 <= WS_MKV && WS_MKV + (size_t)TM * 2048 * 2 <= WS_H8 && WS_H8 + (size_t)T * LD8 <= WS_X && WS_X + (size_t)T * LDH * 2 <= WS_SS && WS_SS + (size_t)T * 32 * 4 <= WS_RS1 && WS_RS1 + (size_t)T * 4 <= WS_RS2 && WS_RS2 + (size_t)T * 4 <= WS_STASH && WS_STASH + (size_t)512 * 65536 <= WS_OC8 && WS_OC8 + (size_t)T * LDC8 <= WS_WBR8 && WS_WBR8 + (size_t)DM * LDC8 <= WS_OA8 && WS_OA8 + (size_t)T * LDC8 <= WS_WBR8A && WS_WBR8A + (size_t)DM * LDC8 <= WS_END && WS_WIN + (size_t)C_QC * LDH * 2 <= WS_W8 && WS_W8 + (size_t)(DIN - C_QC + N8_SWA) * LD8 <= WS_WMEM && WS_WMEM + (size_t)2048 * LD8 <= WS_WBR && WS_HM + (size_t)TM * LD8 <= WS_MKV, "d_ws map");
constexpr int CW_BAR = 4096;
constexpr int TAB_A = 0, TAB_B = 2048, TAB_LAM = 3072;

constexpr int RING_OFF = 0, RING_BYTES = 131072;
constexpr int LDSCTL_OFF = RING_BYTES, MISC_OFF = LDSCTL_OFF + 320;
constexpr int LDS_BYTES = 147456;

namespace att {
using bf16x8 = __attribute__((ext_vector_type(8))) short;
using s16x4  = __attribute__((ext_vector_type(4))) short;
using f32x16 = __attribute__((ext_vector_type(16))) float;
using u32x4  = __attribute__((ext_vector_type(4))) unsigned;
#define ATT_SBAR() __builtin_amdgcn_sched_barrier(0)
#ifndef ATT_MFMA_PRIO
#define ATT_MFMA_PRIO 0
#endif
#if ATT_MFMA_PRIO
#define ATT_PRIO(p) __builtin_amdgcn_s_setprio(p)
#else
#define ATT_PRIO(p) do { } while (0)
#endif
constexpr float THR2 = 8.0f;
__device__ __forceinline__ int crow(int r, int hi) { return (r & 3) + 8 * (r >> 2) + 4 * hi; }
__device__ __forceinline__ unsigned cvtpk(float lo, float hi) { unsigned r; asm volatile("v_cvt_pk_bf16_f32 %0, %1, %2" : "=v"(r) : "v"(lo), "v"(hi)); return r; }
template <int DK> __device__ __forceinline__ int kswz(int row, int ch) {
    if (DK == 64) return row * 128 + ((ch ^ ((row >> 1) & 7)) << 4);
    else return row * (DK * 2) + ((ch ^ (row & 15)) << 4);
}
template <int NDB> __device__ __forceinline__ int v_st(int k, int c) { const int kk = (k & ~0xC) | ((k & 4) << 1) | ((k & 8) >> 1); return ((kk >> 3) * NDB + (c >> 5)) * 512 + ((kk & 7) * 32 + (c & 31)) * 2; }
__device__ __forceinline__ int v_rd_base(int lane) { return ((lane & 3) << 3) | (((lane >> 2) & 3) << 6) | (((lane >> 4) & 1) << 5) | (((lane >> 5) & 1) << 8); }
template <int OFF> __device__ __forceinline__ s16x4 tr_read(int vb) { s16x4 r; asm volatile("ds_read_b64_tr_b16 %0, %1 offset:%2" : "=&v"(r) : "v"(vb), "i"(OFF) : "memory"); return r; }

template <int W> struct TileRegs { u32x4 v[(64 * W / 8) / 512]; };
template <int W> __device__ __forceinline__ void tile_load(TileRegs<W>& R, const bf16* g, size_t ld, int tid) {
    constexpr int CPR = W / 8, N = (64 * CPR) / 512;
#pragma unroll
    for (int i = 0; i < N; ++i) { const int n = tid + 512 * i, row = n / CPR, c = n % CPR; const unsigned off = ((unsigned)row * (unsigned)ld + (unsigned)c * 8u) * 2u;
        R.v[i] = *(const GAS u32x4*)((const GAS unsigned char*)g + off); }
}
template <int DK> __device__ __forceinline__ void tile_write_k(const TileRegs<DK>& R, LAS unsigned char* kb, int tid) {
    constexpr int CPR = DK / 8, N = (64 * CPR) / 512;
#pragma unroll
    for (int i = 0; i < N; ++i) { const int n = tid + 512 * i, row = n / CPR, c = n % CPR; *(LAS u32x4*)(kb + kswz<DK>(row, c)) = R.v[i]; }
}
template <int NDB> __device__ __forceinline__ void tile_write_v(const TileRegs<32 * NDB>& R, LAS unsigned char* vb, int tid) {
    constexpr int CPR = 4 * NDB, N = (64 * CPR) / 512;
#pragma unroll
    for (int i = 0; i < N; ++i) { const int n = tid + 512 * i, row = n / CPR, c = n % CPR; *(LAS u32x4*)(vb + v_st<NDB>(row, c * 8)) = R.v[i]; }
}
template <int DK> __device__ __forceinline__ void qkt(f32x16& p0, f32x16& p1, const LAS unsigned char* kb, const bf16x8* qr, int r32, int hi) {
    p0 = f32x16{}; p1 = f32x16{};
    if constexpr (DK == 64) {
        bf16x8 b0[4], b1[4];
#pragma unroll
        for (int d0 = 0; d0 < 4; ++d0) { b0[d0] = *(const LAS bf16x8*)(kb + kswz<DK>(r32, 2 * d0 + hi)); b1[d0] = *(const LAS bf16x8*)(kb + kswz<DK>(32 + r32, 2 * d0 + hi)); }
        asm volatile("s_waitcnt lgkmcnt(0)" ::: "memory"); ATT_SBAR();
        ATT_PRIO(1);
#pragma unroll
        for (int d0 = 0; d0 < 4; ++d0) { p0 = __builtin_amdgcn_mfma_f32_32x32x16_bf16(b0[d0], qr[d0], p0, 0, 0, 0); p1 = __builtin_amdgcn_mfma_f32_32x32x16_bf16(b1[d0], qr[d0], p1, 0, 0, 0); }
        ATT_PRIO(0);
    } else {
#pragma unroll
        for (int d0 = 0; d0 < DK / 16; ++d0) {
            const bf16x8 b0 = *(const LAS bf16x8*)(kb + kswz<DK>(r32, 2 * d0 + hi));
            const bf16x8 b1 = *(const LAS bf16x8*)(kb + kswz<DK>(32 + r32, 2 * d0 + hi));
            p0 = __builtin_amdgcn_mfma_f32_32x32x16_bf16(b0, qr[d0], p0, 0, 0, 0);
            p1 = __builtin_amdgcn_mfma_f32_32x32x16_bf16(b1, qr[d0], p1, 0, 0, 0); }
    }
}
__device__ __forceinline__ void softmax_tile(f32x16& p0, f32x16& p1, float& m_reg, float& l_reg, float& alpha, bf16x8& pa0, bf16x8& pa1, bf16x8& pa2, bf16x8& pa3) {
    float pmax = p0[0];
#pragma unroll
    for (int r = 1; r < 16; ++r) pmax = fmaxf(pmax, p0[r]);
#pragma unroll
    for (int r = 0; r < 16; ++r) pmax = fmaxf(pmax, p1[r]);
    { auto rr = __builtin_amdgcn_permlane32_swap(__float_as_uint(pmax), __float_as_uint(pmax), false, false); pmax = fmaxf(__uint_as_float(rr[0]), __uint_as_float(rr[1])); }
    if (__builtin_expect(__all(pmax - m_reg <= THR2), 1)) { alpha = 1.f; }
    else { const float mn = fmaxf(m_reg, pmax); alpha = __builtin_amdgcn_exp2f(m_reg - mn); m_reg = mn; }
    float ps = 0.f;
#pragma unroll
    for (int r = 0; r < 16; ++r) { p0[r] = __builtin_amdgcn_exp2f(p0[r] - m_reg); ps += p0[r]; }
#pragma unroll
    for (int r = 0; r < 16; ++r) { p1[r] = __builtin_amdgcn_exp2f(p1[r] - m_reg); ps += p1[r]; }
    { auto rr = __builtin_amdgcn_permlane32_swap(__float_as_uint(ps), __float_as_uint(ps), false, false); ps = __uint_as_float(rr[0]) + __uint_as_float(rr[1]); }
    l_reg = l_reg * alpha + ps;
#define ATT_PK4(P, BASE, OUT) do { unsigned a0 = cvtpk(P[BASE + 0], P[BASE + 1]), a1 = cvtpk(P[BASE + 2], P[BASE + 3]);   \
    unsigned b0 = cvtpk(P[BASE + 4], P[BASE + 5]), b1 = cvtpk(P[BASE + 6], P[BASE + 7]);                              \
    auto r0 = __builtin_amdgcn_permlane32_swap(a0, b0, false, false); auto r1 = __builtin_amdgcn_permlane32_swap(a1, b1, false, false); \
    u32x4 w = {r0[0], r1[0], r0[1], r1[1]}; OUT = __builtin_bit_cast(bf16x8, w); } while (0)
    ATT_PK4(p0, 0, pa0); ATT_PK4(p0, 8, pa1); ATT_PK4(p1, 0, pa2); ATT_PK4(p1, 8, pa3);
#undef ATT_PK4
}
__device__ __forceinline__ void partial_sm(f32x16& p0, f32x16& p1, float& m_reg, float& alpha) {
    float pmax = p0[0];
#pragma unroll
    for (int r = 1; r < 16; ++r) pmax = fmaxf(pmax, p0[r]);
#pragma unroll
    for (int r = 0; r < 16; ++r) pmax = fmaxf(pmax, p1[r]);
    { auto rr = __builtin_amdgcn_permlane32_swap(__float_as_uint(pmax), __float_as_uint(pmax), false, false); pmax = fmaxf(__uint_as_float(rr[0]), __uint_as_float(rr[1])); }
    if (__builtin_expect(__all(pmax - m_reg <= THR2), 1)) { alpha = 1.f; }
    else { const float mn = fmaxf(m_reg, pmax); alpha = __builtin_amdgcn_exp2f(m_reg - mn); m_reg = mn; }
#pragma unroll
    for (int r = 0; r < 16; ++r) { p0[r] = __builtin_amdgcn_exp2f(p0[r] - m_reg); p1[r] = p1[r] - m_reg; }
}
__device__ __forceinline__ void finish_sm(f32x16& p0, f32x16& p1, float alpha, float& l_reg, bf16x8& pa0, bf16x8& pa1, bf16x8& pa2, bf16x8& pa3) {
    float ps = 0.f;
#pragma unroll
    for (int r = 0; r < 16; ++r) { p1[r] = __builtin_amdgcn_exp2f(p1[r]); ps += p0[r] + p1[r]; }
    { auto rr = __builtin_amdgcn_permlane32_swap(__float_as_uint(ps), __float_as_uint(ps), false, false); ps = __uint_as_float(rr[0]) + __uint_as_float(rr[1]); }
    l_reg = l_reg * alpha + ps;
#define ATT_PK4(P, BASE, OUT) do { unsigned a0 = cvtpk(P[BASE + 0], P[BASE + 1]), a1 = cvtpk(P[BASE + 2], P[BASE + 3]);   \
    unsigned b0 = cvtpk(P[BASE + 4], P[BASE + 5]), b1 = cvtpk(P[BASE + 6], P[BASE + 7]);                              \
    auto r0 = __builtin_amdgcn_permlane32_swap(a0, b0, false, false); auto r1 = __builtin_amdgcn_permlane32_swap(a1, b1, false, false); \
    u32x4 w = {r0[0], r1[0], r0[1], r1[1]}; OUT = __builtin_bit_cast(bf16x8, w); } while (0)
    ATT_PK4(p0, 0, pa0); ATT_PK4(p0, 8, pa1); ATT_PK4(p1, 0, pa2); ATT_PK4(p1, 8, pa3);
#undef ATT_PK4
}
template <int NDB, int D0> __device__ __forceinline__ void pv_one(f32x16& od, int vb, bf16x8 pa0, bf16x8 pa1, bf16x8 pa2, bf16x8 pa3) {
    constexpr int KS = NDB * 1024, HF = NDB * 512, B = D0 * 512;
    const s16x4 l0 = tr_read<B + 0 * KS>(vb), h0 = tr_read<B + 0 * KS + HF>(vb), l1 = tr_read<B + 1 * KS>(vb), h1 = tr_read<B + 1 * KS + HF>(vb);
    const s16x4 l2 = tr_read<B + 2 * KS>(vb), h2 = tr_read<B + 2 * KS + HF>(vb), l3 = tr_read<B + 3 * KS>(vb), h3 = tr_read<B + 3 * KS + HF>(vb);
    asm volatile("s_waitcnt lgkmcnt(0)" ::: "memory"); ATT_SBAR();
#define ATT_PK(L, H) (bf16x8){L[0], L[1], L[2], L[3], H[0], H[1], H[2], H[3]}
    od = __builtin_amdgcn_mfma_f32_32x32x16_bf16(pa0, ATT_PK(l0, h0), od, 0, 0, 0);
    od = __builtin_amdgcn_mfma_f32_32x32x16_bf16(pa1, ATT_PK(l1, h1), od, 0, 0, 0);
    od = __builtin_amdgcn_mfma_f32_32x32x16_bf16(pa2, ATT_PK(l2, h2), od, 0, 0, 0);
    od = __builtin_amdgcn_mfma_f32_32x32x16_bf16(pa3, ATT_PK(l3, h3), od, 0, 0, 0);
#undef ATT_PK
}
template <int NDB, int D0> __device__ __forceinline__ void pv_reads(s16x4 (&t)[8], int vb) {
    constexpr int KS = NDB * 1024, HF = NDB * 512, B = D0 * 512;
    t[0] = tr_read<B + 0 * KS>(vb); t[1] = tr_read<B + 0 * KS + HF>(vb); t[2] = tr_read<B + 1 * KS>(vb); t[3] = tr_read<B + 1 * KS + HF>(vb);
    t[4] = tr_read<B + 2 * KS>(vb); t[5] = tr_read<B + 2 * KS + HF>(vb); t[6] = tr_read<B + 3 * KS>(vb); t[7] = tr_read<B + 3 * KS + HF>(vb);
}
__device__ __forceinline__ void pv_mfma(f32x16& od, const s16x4 (&t)[8], bf16x8 pa0, bf16x8 pa1, bf16x8 pa2, bf16x8 pa3) {
#define ATT_PK(L, H) (bf16x8){L[0], L[1], L[2], L[3], H[0], H[1], H[2], H[3]}
    ATT_PRIO(1);
    od = __builtin_amdgcn_mfma_f32_32x32x16_bf16(pa0, ATT_PK(t[0], t[1]), od, 0, 0, 0);
    od = __builtin_amdgcn_mfma_f32_32x32x16_bf16(pa1, ATT_PK(t[2], t[3]), od, 0, 0, 0);
    od = __builtin_amdgcn_mfma_f32_32x32x16_bf16(pa2, ATT_PK(t[4], t[5]), od, 0, 0, 0);
    od = __builtin_amdgcn_mfma_f32_32x32x16_bf16(pa3, ATT_PK(t[6], t[7]), od, 0, 0, 0);
    ATT_PRIO(0);
#undef ATT_PK
}
#define ATT_LGKM(n) asm volatile("s_waitcnt lgkmcnt(" #n ")" ::: "memory")
template <int NDB> __device__ __forceinline__ void pv_pipe4(f32x16 (&o)[4], int vb, bf16x8 pa0, bf16x8 pa1, bf16x8 pa2, bf16x8 pa3) {
    s16x4 ta[8], tb[8];
    pv_reads<NDB, 0>(ta, vb); pv_reads<NDB, 1>(tb, vb);
    ATT_LGKM(8); ATT_SBAR(); pv_mfma(o[0], ta, pa0, pa1, pa2, pa3);
    pv_reads<NDB, 2>(ta, vb);
    ATT_LGKM(8); ATT_SBAR(); pv_mfma(o[1], tb, pa0, pa1, pa2, pa3);
    pv_reads<NDB, 3>(tb, vb);
    ATT_LGKM(8); ATT_SBAR(); pv_mfma(o[2], ta, pa0, pa1, pa2, pa3);
    ATT_LGKM(0); ATT_SBAR(); pv_mfma(o[3], tb, pa0, pa1, pa2, pa3);
}
template <int NDB> __device__ __forceinline__ void pv_pipe2(f32x16 (&o)[2], int vb, bf16x8 pa0, bf16x8 pa1, bf16x8 pa2, bf16x8 pa3) {
    s16x4 ta[8], tb[8];
    pv_reads<NDB, 0>(ta, vb); pv_reads<NDB, 1>(tb, vb);
    ATT_LGKM(8); ATT_SBAR(); pv_mfma(o[0], ta, pa0, pa1, pa2, pa3);
    ATT_LGKM(0); ATT_SBAR(); pv_mfma(o[1], tb, pa0, pa1, pa2, pa3);
}
template <int NO> __device__ __forceinline__ void rescale_o(f32x16 (&o)[NO], float alpha, LAS float* al_l, int r32, int hi) {
    if (__any(alpha < 1.f)) { if (hi == 0) al_l[r32] = alpha; asm volatile("s_waitcnt lgkmcnt(0)" ::: "memory");
#pragma unroll
        for (int r = 0; r < 16; ++r) { const float a = al_l[crow(r, hi)];
#pragma unroll
            for (int d = 0; d < NO; ++d) o[d][r] *= a; } }
}
__device__ __forceinline__ void rows_bcast(float v, float (&out)[16], LAS float* li_l, int r32, int hi) {
    if (hi == 0) li_l[r32] = v; asm volatile("s_waitcnt lgkmcnt(0)" ::: "memory");
#pragma unroll
    for (int r = 0; r < 16; ++r) out[r] = li_l[crow(r, hi)];
}
template <int NO, int QN = 0> __device__ __forceinline__ void store_rows(LAS unsigned char* stg, const f32x16 (&o)[NO], const float (&rs)[16], const float (&cs)[NO], bf16* Og, size_t ld, int lane) {
    constexpr int RB = 64 * NO;
    const int r32 = lane & 31, hi = lane >> 5;
    LAS unsigned char* wp = stg + hi * 4 * RB + r32 * 2;
#pragma unroll
    for (int d = 0; d < NO; ++d)
#pragma unroll
        for (int r = 0; r < 16; ++r) { float v_ = o[d][r] * rs[r] * cs[d]; if (QN > 0) v_ = __uint_as_float((__float_as_uint(v_) + (0x00400000u >> QN)) & ~((0x00800000u >> QN) - 1u)); *(LAS bf16*)(wp + ((r & 3) + 8 * (r >> 2)) * RB + 64 * d) = (bf16)f2bf(v_); }
    asm volatile("s_waitcnt lgkmcnt(0)" ::: "memory");
#pragma unroll
    for (int i = 0; i < 2 * NO; ++i) { const int n = lane + 64 * i, row = n / (4 * NO), c = n % (4 * NO);
        const u32x4 v = *(const LAS u32x4*)(stg + n * 16); *(GAS u32x4*)(Og + (size_t)row * ld + c * 8) = v; }
    asm volatile("s_waitcnt lgkmcnt(0)" ::: "memory");
}
template <int NO> __device__ __forceinline__ void store_rows_f8(LAS unsigned char* stg, const f32x16 (&o)[NO], const float (&rs)[16], float sc8, unsigned char* Og, size_t ld, int lane) {
    constexpr int RB = 32 * NO;
    const int r32 = lane & 31, hi = lane >> 5;
    LAS unsigned char* wp = stg + hi * 4 * RB + r32;
#pragma unroll
    for (int d = 0; d < NO; ++d)
#pragma unroll
        for (int r = 0; r < 16; ++r) { const float v_ = o[d][r] * rs[r] * sc8; const int q_ = __builtin_amdgcn_cvt_pk_fp8_f32(v_, v_, 0, false); *(LAS unsigned char*)(wp + ((r & 3) + 8 * (r >> 2)) * RB + 32 * d) = (unsigned char)q_; }
    asm volatile("s_waitcnt lgkmcnt(0)" ::: "memory");
#pragma unroll
    for (int i = 0; i < NO; ++i) { const int n = lane + 64 * i, row = n / (2 * NO), c = n % (2 * NO);
        const u32x4 v = *(const LAS u32x4*)(stg + n * 16); *(GAS u32x4*)(Og + (size_t)row * ld + c * 16) = v; }
    asm volatile("s_waitcnt lgkmcnt(0)" ::: "memory");
}
}

struct Frame {
    LAS unsigned char* lds;
    volatile LAS unsigned* MISC;
    gu32* ctl;
    int tid, lane, wave;
    int vcu, G, bx;
    unsigned char* ws;
    float* out;
    decltype(__builtin_amdgcn_kernarg_segment_ptr()) karg;
};
#define CAS __attribute__((address_space(4)))
__device__ __forceinline__ const float* inp(const Frame& F, int i) { const GAS float* p = ((const GAS float* const CAS*)(const CAS void*)F.karg)[i]; return (const float*)p; }
__device__ __forceinline__ int lane_now() { int l; asm volatile("v_mbcnt_lo_u32_b32 %0, -1, 0\n\tv_mbcnt_hi_u32_b32 %0, -1, %0" : "=v"(l)); return l; }
#define WSP(off) ((bf16*)(F.ws + (off)))
#define TABP ((float*)(F.ws + WS_TAB))
#define GW (F.vcu * NWAVES + F.wave)
#define NGW (F.G * NWAVES)
typedef unsigned v2u __attribute__((ext_vector_type(2)));
__device__ __forceinline__ float wave_sum(float v) {
#pragma unroll
    for (int o = 1; o < 64; o <<= 1) v += __shfl_xor(v, o);
    return v;
}
__device__ __forceinline__ float wave_max(float v) {
#pragma unroll
    for (int o = 1; o < 64; o <<= 1) v = fmaxf(v, __shfl_xor(v, o));
    return v;
}
__device__ __forceinline__ float bflo(unsigned w) { return __uint_as_float(w << 16); }
__device__ __forceinline__ float bfhi(unsigned w) { return __uint_as_float(w & 0xffff0000u); }
__device__ __forceinline__ float bf1(bf16 h) { return __uint_as_float(((unsigned)h) << 16); }

__device__ __forceinline__ void p0_transpose_item(const float* W, int K, int N, bf16* WT, int ldw, LAS float* scr, int item, int lane, float sc, const float* gk) {
    const int nblk = N / 32, kb = item / nblk, nb = item % nblk, k0 = 64 * kb, n0 = 32 * nb;
#pragma unroll
    for (int i = 0; i < 8; ++i) { const int kk = 8 * i + (lane >> 3); const f32x4 w = *(const GAS f32x4*)(W + (size_t)(k0 + kk) * N + n0 + 4 * (lane & 7)); const float g_ = gk ? sc * gk[k0 + kk] : sc;
        *(LAS f32x4*)(scr + kk * 36 + 4 * (lane & 7)) = (f32x4){w.x * g_, w.y * g_, w.z * g_, w.w * g_}; }
    LDS_WAIT(); asm volatile("" ::: "memory");
    const int c = lane & 7;
#pragma unroll
    for (int j = 0; j < 4; ++j) { const int n = (lane >> 3) + 8 * j; const LAS float* s = scr + (8 * c) * 36 + n;
        v4u o; o.x = pk2(s[0 * 36], s[1 * 36]); o.y = pk2(s[2 * 36], s[3 * 36]); o.z = pk2(s[4 * 36], s[5 * 36]); o.w = pk2(s[6 * 36], s[7 * 36]);
        *(GAS v4u*)(WT + (size_t)(n0 + n) * ldw + k0 + 8 * c) = o; }
    LDS_WAIT(); asm volatile("" ::: "memory");
}
__device__ __forceinline__ unsigned pk4_fp8(float a, float b, float c, float d) { int r = 0; r = __builtin_amdgcn_cvt_pk_fp8_f32(a, b, r, false); r = __builtin_amdgcn_cvt_pk_fp8_f32(c, d, r, true); return (unsigned)r; }
__device__ __forceinline__ void p0_transpose_item_f8(const float* W, int K, int N, unsigned char* WT8, int ld8, int n_base, LAS float* scr, int item, int lane, float sc, const float* gk) {
    const int nblk = N / 32, kb = item / nblk, nb = item % nblk, k0 = 64 * kb, n0 = 32 * nb;
#pragma unroll
    for (int i = 0; i < 8; ++i) { const int kk = 8 * i + (lane >> 3); const f32x4 w = *(const GAS f32x4*)(W + (size_t)(k0 + kk) * N + n0 + 4 * (lane & 7)); const float g_ = gk ? sc * gk[k0 + kk] : sc;
        *(LAS f32x4*)(scr + kk * 36 + 4 * (lane & 7)) = (f32x4){w.x * g_, w.y * g_, w.z * g_, w.w * g_}; }
    LDS_WAIT(); asm volatile("" ::: "memory");
    const int c = lane & 7;
#pragma unroll
    for (int j = 0; j < 4; ++j) { const int n = (lane >> 3) + 8 * j; const LAS float* s = scr + (8 * c) * 36 + n;
        v2u o; o.x = pk4_fp8(s[0 * 36], s[1 * 36], s[2 * 36], s[3 * 36]); o.y = pk4_fp8(s[4 * 36], s[5 * 36], s[6 * 36], s[7 * 36]);
        *(GAS v2u*)(WT8 + (size_t)(n0 - n_base + n) * ld8 + k0 + 8 * c) = o; }
    LDS_WAIT(); asm volatile("" ::: "memory");
}
__device__ __forceinline__ void rms_row_bf16_f8(const float* xrow, const float* g, bf16* orow, unsigned char* o8row, int lane, float eps) {
    const GAS f32x4* xr = (const GAS f32x4*)xrow + lane; const GAS f32x4* gr = (const GAS f32x4*)g + lane;
    f32x4 v[8]; float s = 0.f;
#pragma unroll
    for (int j = 0; j < 8; ++j) { v[j] = xr[64 * j]; s += (v[j].x * v[j].x + v[j].y * v[j].y) + (v[j].z * v[j].z + v[j].w * v[j].w); }
    const float rs = 1.0f / sqrtf(wave_sum(s) * (1.f / DM) + eps);
    GAS v2u* o8 = (GAS v2u*)orow + lane; GAS unsigned* o4 = (GAS unsigned*)o8row + lane;
#pragma unroll
    for (int j = 0; j < 8; ++j) { const f32x4 gg = gr[64 * j]; const float a = v[j].x * rs * gg.x, b = v[j].y * rs * gg.y, c = v[j].z * rs * gg.z, d = v[j].w * rs * gg.w;
        v2u o; o.x = pk2(a, b); o.y = pk2(c, d); o8[64 * j] = o; o4[64 * j] = pk4_fp8(a, b, c, d); }
}
__device__ __forceinline__ void rms_row_f8(const float* xrow, const float* g, unsigned char* o8row, int lane, float eps) {
    const GAS f32x4* xr = (const GAS f32x4*)xrow + lane; const GAS f32x4* gr = (const GAS f32x4*)g + lane;
    f32x4 v[8]; float s = 0.f;
#pragma unroll
    for (int j = 0; j < 8; ++j) { v[j] = xr[64 * j]; s += (v[j].x * v[j].x + v[j].y * v[j].y) + (v[j].z * v[j].z + v[j].w * v[j].w); }
    const float rs = 1.0f / sqrtf(wave_sum(s) * (1.f / DM) + eps);
    GAS unsigned* o4 = (GAS unsigned*)o8row + lane;
    f32x4 gg[8];
#pragma unroll
    for (int j = 0; j < 8; ++j) gg[j] = gr[64 * j];
    asm volatile("" ::: "memory");
#pragma unroll
    for (int j = 0; j < 8; ++j) o4[64 * j] = pk4_fp8(v[j].x * rs * gg[j].x, v[j].y * rs * gg[j].y, v[j].z * rs * gg[j].z, v[j].w * rs * gg[j].w);
}
__device__ __forceinline__ void rms_row_bf16(const float* xrow, const float* g, bf16* orow, int lane, float eps) {
    const GAS f32x4* xr = (const GAS f32x4*)xrow + lane; const GAS f32x4* gr = (const GAS f32x4*)g + lane;
    f32x4 v[8]; float s = 0.f;
#pragma unroll
    for (int j = 0; j < 8; ++j) { v[j] = xr[64 * j]; s += (v[j].x * v[j].x + v[j].y * v[j].y) + (v[j].z * v[j].z + v[j].w * v[j].w); }
    const float rs = 1.0f / sqrtf(wave_sum(s) * (1.f / DM) + eps);
    GAS v2u* o8 = (GAS v2u*)orow + lane;
    f32x4 gg[8];
#pragma unroll
    for (int j = 0; j < 8; ++j) gg[j] = gr[64 * j];
    asm volatile("" ::: "memory");
#pragma unroll
    for (int j = 0; j < 8; ++j) { v2u o; o.x = pk2(v[j].x * rs * gg[j].x, v[j].y * rs * gg[j].y); o.y = pk2(v[j].z * rs * gg[j].z, v[j].w * rs * gg[j].w); o8[64 * j] = o; }
}
__device__ __forceinline__ void rms_row_f32(const float* xrow, const float* g, float* orow, int lane, float eps) {
    const GAS f32x4* xr = (const GAS f32x4*)xrow + lane; const GAS f32x4* gr = (const GAS f32x4*)g + lane;
    f32x4 v[8]; float s = 0.f;
#pragma unroll
    for (int j = 0; j < 8; ++j) { v[j] = xr[64 * j]; s += (v[j].x * v[j].x + v[j].y * v[j].y) + (v[j].z * v[j].z + v[j].w * v[j].w); }
    const float rs = 1.0f / sqrtf(wave_sum(s) * (1.f / DM) + eps);
    GAS f32x4* o = (GAS f32x4*)orow + lane;
#pragma unroll
    for (int j = 0; j < 8; ++j) { const f32x4 gg = gr[64 * j]; o[64 * j] = (f32x4){v[j].x * rs * gg.x, v[j].y * rs * gg.y, v[j].z * rs * gg.z, v[j].w * rs * gg.w}; }
}
__device__ __forceinline__ int t5_bucket(int n) {
    if (n < 16) return n < 0 ? 0 : n;
    int b = 16;
    b += (n >= 19) + (n >= 21) + (n >= 24) + (n >= 27) + (n >= 31) + (n >= 35) + (n >= 40) + (n >= 46) + (n >= 52) + (n >= 59) + (n >= 67) + (n >= 77) + (n >= 87) + (n >= 99) + (n >= 113);
    return b;
}
__device__ __forceinline__ void x0_row(const float* xrow, bf16* orow, unsigned char* o8row, float* rs, int lane, float eps) {
    const GAS f32x4* xr = (const GAS f32x4*)xrow + lane;
    f32x4 v[8]; float s = 0.f;
#pragma unroll
    for (int j = 0; j < 8; ++j) { v[j] = xr[64 * j]; s += (v[j].x * v[j].x + v[j].y * v[j].y) + (v[j].z * v[j].z + v[j].w * v[j].w); }
    const float r = 1.0f / sqrtf(wave_sum(s) * (1.f / DM) + eps);
    if (lane == 0) *(GAS float*)rs = r;
    GAS v2u* o8 = (GAS v2u*)orow + lane; GAS unsigned* o4 = (GAS unsigned*)o8row + lane;
#pragma unroll
    for (int j = 0; j < 8; ++j) { v2u o; o.x = pk2(v[j].x, v[j].y); o.y = pk2(v[j].z, v[j].w); o8[64 * j] = o; o4[64 * j] = pk4_fp8(v[j].x, v[j].y, v[j].z, v[j].w); }
}
__device__ __forceinline__ void x8_row(const bf16* xrow, unsigned char* o8row, int lane) {
    const GAS v2u* xr = (const GAS v2u*)xrow + lane; GAS unsigned* o4 = (GAS unsigned*)o8row + lane;
    v2u w[8];
#pragma unroll
    for (int j = 0; j < 8; ++j) w[j] = xr[64 * j];
#pragma unroll
    for (int j = 0; j < 8; ++j) o4[64 * j] = pk4_fp8(bflo(w[j].x), bfhi(w[j].x), bflo(w[j].y), bfhi(w[j].y));
}
__device__ __forceinline__ void rs_from_ss(Frame& F, float* rs) {
    const GAS f32x4* ss = (const GAS f32x4*)(F.ws + WS_SS);
    for (int r = (F.vcu * NWAVES + F.wave) * 64 + F.lane; r < T; r += F.G * NWAVES * 64) { float s = 0.f;
#pragma unroll
        for (int j = 0; j < 8; ++j) { const f32x4 p = ss[(size_t)r * 8 + j]; s += (p.x + p.y) + (p.z + p.w); }
        ((GAS float*)rs)[r] = 1.0f / sqrtf(s * (1.f / DM) + RMS_EPS); }
}
__device__ __forceinline__ void final_row(Frame& F, int row, const float* g, float* orow) {
    const float p = (F.lane < 32) ? ((const GAS float*)(F.ws + WS_SS))[(size_t)row * 32 + F.lane] : 0.f;
    const float rs = 1.0f / sqrtf(wave_sum(p) * (1.f / DM) + RMS_EPS);
    const GAS v2u* xr = (const GAS v2u*)(WSP(WS_X) + (size_t)row * LDH) + F.lane; const GAS f32x4* gr = (const GAS f32x4*)g + F.lane; GAS f32x4* o = (GAS f32x4*)orow + F.lane;
    v2u w[8]; f32x4 gg[8];
#pragma unroll
    for (int j = 0; j < 8; ++j) { w[j] = xr[64 * j]; gg[j] = gr[64 * j]; }
    asm volatile("" ::: "memory");
#pragma unroll
    for (int j = 0; j < 8; ++j) o[64 * j] = (f32x4){bflo(w[j].x) * rs * gg[j].x, bfhi(w[j].x) * rs * gg[j].y, bflo(w[j].y) * rs * gg[j].z, bfhi(w[j].y) * rs * gg[j].w};
}
__device__ __forceinline__ void phase_a(Frame& F, int l, const float* xin) {
    LAS float* scr = (LAS float*)(F.lds + RING_OFF + F.wave * 16384);
    const int gw = GW;
    constexpr int I_IN = (DM / 64) * (DIN / 32), I_MEM = (DM / 64) * (2048 / 32), I_BR = (BW / 64) * (DM / 32), I_OUT = (DM / 64) * (DM / 32), I_1 = (DM / 64) * (DFF / 32), I_2 = (DFF / 64) * (DM / 32);
    constexpr int NITEMS = I_IN + I_MEM + 3 * I_BR + I_OUT + I_1 + I_2;
    const float* w_in = inp(F, 4) + (size_t)l * DM * DIN; const float* w_mem = inp(F, 13) + (size_t)l * DM * 2048; const float* w_br = inp(F, 14) + (size_t)l * 3 * BW * DM;
    const float* w_out = inp(F, 15) + (size_t)l * DM * DM; const float* w_1 = inp(F, 17) + (size_t)l * DM * DFF; const float* w_2 = inp(F, 18) + (size_t)l * DFF * DM;
    for (int it = gw; it < NITEMS; it += NGW) {
        int r = it;
        if (r < I_IN) { const int n0 = 32 * (r % (DIN / 32));
            if (n0 >= C_QC) { p0_transpose_item_f8(w_in, DM, DIN, (unsigned char*)(F.ws + WS_W8), LD8, C_QC - N8_SWA, scr, r, F.lane, W8_SCALE, inp(F, 3) + (size_t)l * DM); continue; }
            if (n0 < N8_SWA) { p0_transpose_item_f8(w_in, DM, DIN, (unsigned char*)(F.ws + WS_W8), LD8, 0, scr, r, F.lane, W8_SCALE, inp(F, 3) + (size_t)l * DM); continue; }
            const float sc = (n0 < C_KA) ? QS_A : (n0 >= C_QB && n0 < C_KB) ? QS_A : 1.0f;
            p0_transpose_item(w_in, DM, DIN, WSP(WS_WIN), LDH, scr, r, F.lane, sc, inp(F, 3) + (size_t)l * DM); continue; } r -= I_IN;
        if (r < I_MEM) { p0_transpose_item_f8(w_mem, DM, 2048, (unsigned char*)(F.ws + WS_WMEM), LD8, 0, scr, r, F.lane, W8_SCALE, nullptr); continue; } r -= I_MEM;
        if (r < 3 * I_BR) { const int b = r / I_BR;
            if (b != 1) { p0_transpose_item_f8(w_br + (size_t)b * BW * DM, BW, DM, (unsigned char*)(F.ws + (b == 2 ? WS_WBR8 : WS_WBR8A)), LDC8, 0, scr, r - b * I_BR, F.lane, W8_SCALE, nullptr); continue; }
            p0_transpose_item(w_br + (size_t)b * BW * DM, BW, DM, WSP(WS_WBR) + (size_t)b * DM * LDB, LDB, scr, r - b * I_BR, F.lane, 1.0f, nullptr); continue; } r -= 3 * I_BR;
        if (r < I_OUT) { p0_transpose_item(w_out, DM, DM, WSP(WS_WOUT), LDH, scr, r, F.lane, 1.0f, nullptr); continue; } r -= I_OUT;
        if (r < I_1) { p0_transpose_item(w_1, DM, DFF, WSP(WS_W1), LDH, scr, r, F.lane, 1.0f, inp(F, 16) + (size_t)l * DM); continue; } r -= I_1;
        p0_transpose_item(w_2, DFF, DM, WSP(WS_W2), LDU, scr, r, F.lane, 1.0f, nullptr);
    }
    if (l == 0) { for (int m = gw; m < T; m += NGW) x0_row(xin + (size_t)m * DM, WSP(WS_X) + (size_t)m * LDH, (unsigned char*)(F.ws + WS_H8) + (size_t)m * LD8, (float*)(F.ws + WS_RS1) + m, F.lane, RMS_EPS); }
    else rs_from_ss(F, (float*)(F.ws + WS_RS1));
    for (int m = gw; m < TM; m += NGW) rms_row_f8(inp(F, 1) + (size_t)m * DM, inp(F, 12) + (size_t)l * DM, (unsigned char*)(F.ws + WS_HM) + (size_t)m * LD8, F.lane, RMS_EPS);
    if (blockIdx.x == 0) {
        const float* rb = inp(F, 2);
        if (l == 0) {
            for (int i = F.tid; i < 16 * 128; i += NWAVES * 64) { const int h = i >> 7, d = i & 127; TABP[TAB_A + i] = rb[t5_bucket(d) * 24 + h] * LOG2E; }
            for (int i = F.tid; i < 8 * 128; i += NWAVES * 64) { const int h = i >> 7, d = i & 127; TABP[TAB_B + i] = rb[t5_bucket(d) * 24 + 16 + h] * LOG2E; }
        }
        if (F.wave == 0) {
            const float a = wave_sum(inp(F, 7)[l * 64 + F.lane] * inp(F, 8)[l * 64 + F.lane]), b = wave_sum(inp(F, 9)[l * 64 + F.lane] * inp(F, 10)[l * 64 + F.lane]);
            const float lam_init = 0.8f - 0.6f * expf(-0.3f * (float)l);
            if (F.lane == 0) TABP[TAB_LAM + l] = expf(a) - expf(b) + lam_init;
        }
    }
}

__device__ __forceinline__ void swa_naive_item(Frame& F, int t, int h, float sink2, LAS float* scr) {
    const int lane = F.lane, s = t & (SEQ - 1), hk = h >> 3;
    bf16* zrow = WSP(WS_Z) + (size_t)t * DIN;
    float q[64];
#pragma unroll
    for (int c = 0; c < 8; ++c) { const v4u w = *(const GAS v4u*)(zrow + C_QA + h * 64 + c * 8);
        q[c * 8 + 0] = bflo(w.x); q[c * 8 + 1] = bfhi(w.x); q[c * 8 + 2] = bflo(w.y); q[c * 8 + 3] = bfhi(w.y); q[c * 8 + 4] = bflo(w.z); q[c * 8 + 5] = bfhi(w.z); q[c * 8 + 6] = bflo(w.w); q[c * 8 + 7] = bfhi(w.w); }
    float sc[2];
#pragma unroll
    for (int j = 0; j < 2; ++j) { const int i = lane + 64 * j, kpos = s - 127 + i; const bool valid = kpos >= 0;
        const bf16* krow = WSP(WS_Z) + (size_t)(valid ? t - 127 + i : t) * DIN + C_KA + hk * 64; float d = 0.f;
#pragma unroll
        for (int c = 0; c < 8; ++c) { const v4u w = *(const GAS v4u*)(krow + c * 8);
            d += q[c * 8 + 0] * bflo(w.x) + q[c * 8 + 1] * bfhi(w.x) + q[c * 8 + 2] * bflo(w.y) + q[c * 8 + 3] * bfhi(w.y) + q[c * 8 + 4] * bflo(w.z) + q[c * 8 + 5] * bfhi(w.z) + q[c * 8 + 6] * bflo(w.w) + q[c * 8 + 7] * bfhi(w.w); }
        sc[j] = valid ? d + TABP[TAB_A + h * 128 + (127 - i)] : -INFINITY; }
    const float m = fmaxf(wave_max(fmaxf(sc[0], sc[1])), sink2);
    const float p0 = __builtin_amdgcn_exp2f(sc[0] - m), p1 = __builtin_amdgcn_exp2f(sc[1] - m);
    const float den = wave_sum(p0 + p1) + __builtin_amdgcn_exp2f(sink2 - m);
    scr[lane] = p0; scr[lane + 64] = p1;
    float acc = 0.f;
    const int i0 = (s >= 127) ? 0 : 127 - s;
    for (int i = i0; i < 128; ++i) acc += scr[i] * bf1(WSP(WS_Z)[(size_t)(t - 127 + i) * DIN + C_VA + hk * 64 + lane]);
    zrow[C_QA + h * 64 + lane] = (bf16)f2bf(acc / den);
}
__device__ __forceinline__ void diff_naive_item(Frame& F, int t, int h, float lam, float ln_scale, const float* subg, LAS float* scr) {
    const int lane = F.lane, s = t & (SEQ - 1), tb = t - s;
    bf16* zrow = WSP(WS_Z) + (size_t)t * DIN;
    LAS float* sc1 = scr; LAS float* sc2 = scr + 2048;
    float mx[2];
#pragma unroll
    for (int mp = 0; mp < 2; ++mp) {
        float q[64];
#pragma unroll
        for (int c = 0; c < 8; ++c) { const v4u w = *(const GAS v4u*)(zrow + C_QB + h * 128 + mp * 64 + c * 8);
            q[c * 8 + 0] = bflo(w.x); q[c * 8 + 1] = bfhi(w.x); q[c * 8 + 2] = bflo(w.y); q[c * 8 + 3] = bfhi(w.y); q[c * 8 + 4] = bflo(w.z); q[c * 8 + 5] = bfhi(w.z); q[c * 8 + 6] = bflo(w.w); q[c * 8 + 7] = bfhi(w.w); }
        LAS float* sc = mp ? sc2 : sc1; float m = -INFINITY;
        for (int c0 = 0; c0 <= s; c0 += 64) { const int key = c0 + lane; const bool valid = key <= s;
            const bf16* krow = WSP(WS_Z) + (size_t)(tb + (valid ? key : s)) * DIN + C_KB + h * 128 + mp * 64; float d = 0.f;
#pragma unroll
            for (int c = 0; c < 8; ++c) { const v4u w = *(const GAS v4u*)(krow + c * 8);
                d += q[c * 8 + 0] * bflo(w.x) + q[c * 8 + 1] * bfhi(w.x) + q[c * 8 + 2] * bflo(w.y) + q[c * 8 + 3] * bfhi(w.y) + q[c * 8 + 4] * bflo(w.z) + q[c * 8 + 5] * bfhi(w.z) + q[c * 8 + 6] * bflo(w.w) + q[c * 8 + 7] * bfhi(w.w); }
            const int dist = s - key; const float v = valid ? d + TABP[TAB_B + h * 128 + (dist > 127 ? 127 : dist)] : -INFINITY;
            sc[key] = v; m = fmaxf(m, v); }
        mx[mp] = wave_max(m);
    }
    float l1 = 0.f, l2 = 0.f;
    for (int c0 = 0; c0 <= s; c0 += 64) { const int key = c0 + lane; const float a = __builtin_amdgcn_exp2f(sc1[key] - mx[0]), b = __builtin_amdgcn_exp2f(sc2[key] - mx[1]); sc1[key] = a; sc2[key] = b; l1 += a; l2 += b; }
    l1 = wave_sum(l1); l2 = wave_sum(l2);
    const float r1 = 1.0f / l1, r2 = lam / l2;
    for (int c0 = 0; c0 <= s; c0 += 64) { const int key = c0 + lane; sc1[key] = sc1[key] * r1 - sc2[key] * r2; }
    float a0 = 0.f, a1 = 0.f;
    const bf16* vb = WSP(WS_Z) + (size_t)tb * DIN + C_VB + h * 128 + 2 * lane;
    for (int key = 0; key <= s; ++key) { const unsigned w = *(const GAS unsigned*)(vb + (size_t)key * DIN); const float a = sc1[key]; a0 += a * bflo(w); a1 += a * bfhi(w); }
    const float ss = wave_sum(a0 * a0 + a1 * a1) * (1.0f / 128.0f);
    const float rs = ln_scale / sqrtf(ss + SUBLN_EPS);
    *(GAS unsigned*)(zrow + C_QB + h * 128 + 2 * lane) = pk2(a0 * rs * subg[2 * lane], a1 * rs * subg[2 * lane + 1]);
}
__device__ __forceinline__ void mem_naive_item(Frame& F, int t, int hc, LAS float* scr) {
    const int lane = F.lane, b = t >> 11;
    bf16* zrow = WSP(WS_Z) + (size_t)t * DIN;
    LAS float* qs = scr; LAS float* ps = scr + 256;
    { const v2u w = *(const GAS v2u*)(zrow + C_QC + hc * 256 + 4 * lane); qs[4 * lane + 0] = bflo(w.x); qs[4 * lane + 1] = bfhi(w.x); qs[4 * lane + 2] = bflo(w.y); qs[4 * lane + 3] = bfhi(w.y); }
    float d[4] = {0.f, 0.f, 0.f, 0.f};
    const bf16* kb = WSP(WS_MKV) + (size_t)(b * NMEM + lane) * 2048 + hc * 256;
    for (int c = 0; c < 32; ++c) {
        float q[8];
#pragma unroll
        for (int e = 0; e < 8; ++e) q[e] = qs[c * 8 + e];
#pragma unroll
        for (int j = 0; j < 4; ++j) { const v4u w = *(const GAS v4u*)(kb + (size_t)(64 * j) * 2048 + c * 8);
            d[j] += q[0] * bflo(w.x) + q[1] * bfhi(w.x) + q[2] * bflo(w.y) + q[3] * bfhi(w.y) + q[4] * bflo(w.z) + q[5] * bfhi(w.z) + q[6] * bflo(w.w) + q[7] * bfhi(w.w); }
    }
    const float m = wave_max(fmaxf(fmaxf(d[0], d[1]), fmaxf(d[2], d[3])));
    float sum = 0.f;
#pragma unroll
    for (int j = 0; j < 4; ++j) { const float p = __builtin_amdgcn_exp2f(d[j] - m); ps[lane + 64 * j] = p; sum += p; }
    sum = wave_sum(sum);
    float a0 = 0.f, a1 = 0.f, a2 = 0.f, a3 = 0.f;
    const bf16* vb = WSP(WS_MKV) + (size_t)(b * NMEM) * 2048 + 1024 + hc * 256 + 4 * lane;
    for (int key = 0; key < NMEM; ++key) { const v2u w = *(const GAS v2u*)(vb + (size_t)key * 2048); const float p = ps[key]; a0 += p * bflo(w.x); a1 += p * bfhi(w.x); a2 += p * bflo(w.y); a3 += p * bfhi(w.y); }
    const float r = 1.0f / sum;
    v2u o; o.x = pk2(a0 * r, a1 * r); o.y = pk2(a2 * r, a3 * r);
    *(GAS v2u*)(zrow + C_QC + hc * 256 + 4 * lane) = o;
}


constexpr int SCR_OFF = LDSCTL_OFF + 1024;
constexpr int TBL_OFF = LDSCTL_OFF + 4096;
constexpr int DIFF_STASH = 49152;
static_assert(TBL_OFF + 8 * 224 * 4 <= LDS_BYTES, "attention LDS map");

template <int VAR = 0>
__device__ __forceinline__ void diff_unit(Frame& F, int b, int h, int qb, float lam, float ln_scale, const float* subg, bf16* Ob, size_t ldo) {
    using namespace att;
    const int tid_ = lane_now() + 64 * F.wave;
    const int tid = tid_, lane = tid & 63, wid = F.wave, r32 = lane & 31, hi = lane >> 5;
    LAS unsigned char* L = F.lds;
    LAS float* tbl = (LAS float*)(L + TBL_OFF);
    LAS float* al_l = (LAS float*)(L + SCR_OFF + wid * 256); LAS float* li_l = al_l + 32;
    GAS u32x4* stash = (GAS u32x4*)(F.ws + WS_STASH + (size_t)F.bx * 65536 + wid * 8192) + lane;
    { const float* TB = TABP + TAB_B + h * 128;
      if (tid < 208) { const int dist = tid - 94; tbl[tid] = dist < 0 ? -INFINITY : (dist > 112 ? 0.f : TB[dist] - TB[127]); } }
    const int q0 = qb * 256, qw = q0 + 32 * wid;
    const bf16* Zb = WSP(WS_Z) + (size_t)b * SEQ * DIN;
    const int NT = 4 * (qb + 1);
    const int lbase = (int)(unsigned)(size_t)L;
    constexpr int KS = 8192, VS = 16384, VOFF = 3 * KS;
    __syncthreads();
#pragma unroll 1
    for (int mp = 0; mp < 2; ++mp) {
        const bf16* Kg = Zb + C_KB + h * 128 + mp * 64; const bf16* Vg = Zb + C_VB + h * 128;
        bf16x8 qr[4];
        { int rq_ = r32; asm volatile("" : "+v"(rq_));
          const bf16* Qw = Zb + (size_t)(qw + rq_) * DIN + C_QB + h * 128 + mp * 64 + hi * 8;
#pragma unroll
          for (int d0 = 0; d0 < 4; ++d0) qr[d0] = *(const GAS bf16x8*)(Qw + d0 * 16); }
        float m_reg = -1e30f, l_reg = 0.f; f32x16 o[4];
#pragma unroll
        for (int d = 0; d < 4; ++d) o[d] = f32x16{};
        TileRegs<64> kr; TileRegs<128> vr;
        f32x16 pA0, pA1, pB0, pB1; float alA = 1.f, alB = 1.f; bf16x8 pa0, pa1, pa2, pa3;
#define DIFF_MASK(P0, P1, J) do { if (64 * (J) + 63 + 113 > qw) { int rr_ = r32 - 4 * hi; asm volatile("" : "+v"(rr_)); const int base_ = qw - 64 * (J) + 94 + rr_;     \
            _Pragma("unroll") for (int r = 0; r < 16; ++r) { int i0 = base_ - ((r & 3) + 8 * (r >> 2)), i1 = i0 - 32; i0 = i0 > 207 ? 207 : (i0 < 0 ? 0 : i0); i1 = i1 > 207 ? 207 : (i1 < 0 ? 0 : i1); P0[r] += tbl[i0]; P1[r] += tbl[i1]; } } } while (0)
#define DIFF_PV(SL) do { const int vb_ = lbase + VOFF + (SL) * VS + v_rd_base(lane); \
            pv_pipe4<4>(o, vb_, pa0, pa1, pa2, pa3); } while (0)
#define DIFF_STEP(PC0, PC1, ALC, PP0, PP1, ALP, J, SC, SP, SN) do { \
            if (VAR != 4 && (J) + 1 < NT) { tile_load<64>(kr, Kg + (size_t)((J) + 1) * 64 * DIN, DIN, tid); tile_load<128>(vr, Vg + (size_t)((J) + 1) * 64 * DIN, DIN, tid); } \
            ATT_SBAR(); if constexpr (VAR != 3) qkt<64>(PC0, PC1, L + (SC) * KS, qr, r32, hi); \
            if constexpr (VAR != 2) finish_sm(PP0, PP1, ALP, l_reg, pa0, pa1, pa2, pa3); ATT_SBAR(); \
            DIFF_MASK(PC0, PC1, J); ATT_SBAR(); \
            if constexpr (VAR != 1) DIFF_PV(SP); \
            if constexpr (VAR != 2) { partial_sm(PC0, PC1, m_reg, ALC); ATT_SBAR(); rescale_o<4>(o, ALC, al_l, r32, hi); } ATT_SBAR(); \
            if (VAR != 4 && (J) + 1 < NT) { tile_write_k<64>(kr, L + (SN) * KS, tid); tile_write_v<4>(vr, L + VOFF + (SN) * VS, tid); } \
            __syncthreads(); } while (0)
        tile_load<64>(kr, Kg, DIN, tid); tile_load<128>(vr, Vg, DIN, tid);
        tile_write_k<64>(kr, L, tid); tile_write_v<4>(vr, L + VOFF, tid);
        __syncthreads();
        tile_load<64>(kr, Kg + (size_t)64 * DIN, DIN, tid); tile_load<128>(vr, Vg + (size_t)64 * DIN, DIN, tid);
        qkt<64>(pA0, pA1, L, qr, r32, hi); DIFF_MASK(pA0, pA1, 0); partial_sm(pA0, pA1, m_reg, alA);
        tile_write_k<64>(kr, L + KS, tid); tile_write_v<4>(vr, L + VOFF + VS, tid);
        __syncthreads();
        int sc = 1, sp = 0, sn = 2;
#pragma unroll 1
        for (int j = 1; j + 1 < NT; j += 2) {
            DIFF_STEP(pB0, pB1, alB, pA0, pA1, alA, j, sc, sp, sn);
            { const int t_ = sp; sp = sc; sc = sn; sn = t_; }
            DIFF_STEP(pA0, pA1, alA, pB0, pB1, alB, j + 1, sc, sp, sn);
            { const int t_ = sp; sp = sc; sc = sn; sn = t_; }
        }
        DIFF_STEP(pB0, pB1, alB, pA0, pA1, alA, NT - 1, sc, sp, sn);
        finish_sm(pB0, pB1, alB, l_reg, pa0, pa1, pa2, pa3); DIFF_PV(sc);
        __syncthreads();
#undef DIFF_STEP
#undef DIFF_PV
#undef DIFF_MASK
        float rl[16]; rows_bcast(1.0f / l_reg, rl, li_l, r32, hi);
        if (mp == 0) {
#pragma unroll
            for (int d = 0; d < 4; ++d)
#pragma unroll
                for (int q = 0; q < 2; ++q) { u32x4 w; const int r = 8 * q;
                    w.x = cvtpk(o[d][r] * rl[r], o[d][r + 1] * rl[r + 1]); w.y = cvtpk(o[d][r + 2] * rl[r + 2], o[d][r + 3] * rl[r + 3]);
                    w.z = cvtpk(o[d][r + 4] * rl[r + 4], o[d][r + 5] * rl[r + 5]); w.w = cvtpk(o[d][r + 6] * rl[r + 6], o[d][r + 7] * rl[r + 7]);
                    stash[(d * 2 + q) * 64] = w; }
        } else {
            float ss[16];
#pragma unroll
            for (int r = 0; r < 16; ++r) ss[r] = 0.f;
#pragma unroll
            for (int d = 0; d < 4; ++d)
#pragma unroll
                for (int q = 0; q < 2; ++q) { const u32x4 w = stash[(d * 2 + q) * 64]; const unsigned wv[4] = {w.x, w.y, w.z, w.w};
#pragma unroll
                    for (int e = 0; e < 4; ++e) { const int r = 8 * q + 2 * e;
                        const float c0 = bflo(wv[e]) - lam * (o[d][r] * rl[r]), c1 = bfhi(wv[e]) - lam * (o[d][r + 1] * rl[r + 1]);
                        o[d][r] = c0; o[d][r + 1] = c1; ss[r] += c0 * c0; ss[r + 1] += c1 * c1; } }
#pragma unroll
            for (int r = 0; r < 16; ++r) {
#pragma unroll
                for (int off = 1; off < 32; off <<= 1) ss[r] += __shfl_xor(ss[r], off);
                ss[r] = ln_scale / sqrtf(ss[r] * (1.0f / 128.0f) + SUBLN_EPS); }
            int lane_e = lane; asm volatile("" : "+v"(lane_e));
            float cs[4];
#pragma unroll
            for (int d = 0; d < 4; ++d) cs[d] = subg[32 * d + (lane_e & 31)];
            store_rows<4, PROBE_QOB>(L + wid * 8192, o, ss, cs, Ob + ((size_t)b * SEQ + qw) * ldo + h * 128, ldo, lane_e);
        }
    }
}
__device__ __forceinline__ void swa_unit(Frame& F, int b, int hk, int rb, const float* sinks_l, bf16* Ob, size_t ldo, bool fill_tbl, unsigned char* O8) {
    using namespace att;
    const int tid_ = lane_now() + 64 * F.wave;
    const int tid = tid_, lane = tid & 63, wid = F.wave, r32 = lane & 31, hi = lane >> 5;
    LAS unsigned char* L = F.lds;
    LAS float* tbl = (LAS float*)(L + TBL_OFF) + wid * 224;
    LAS float* al_l = (LAS float*)(L + SCR_OFF + wid * 256); LAS float* li_l = al_l + 32;
    const int h = hk * 8 + wid;
    if (fill_tbl) { const float* TA = TABP + TAB_A + hk * 8 * 128; LAS float* tb = (LAS float*)(L + TBL_OFF);
      for (int i = tid; i < 8 * 224; i += NWAVES * 64) { const int w = i / 224, dist = (i - w * 224) - 63; tb[i] = (dist < 0 || dist > 127) ? -INFINITY : TA[w * 128 + dist]; } }
    const int s0 = 64 * rb, a = rb, j0 = a >= 2 ? a - 2 : 0, NT = a - j0 + 1;
    const bf16* Zb = WSP(WS_Z) + (size_t)b * SEQ * DIN;
    const bf16* Kg = Zb + (size_t)j0 * 64 * DIN + C_KA + hk * 64; const bf16* Vg = Zb + (size_t)j0 * 64 * DIN + C_VA + hk * 64;
    const int lbase = (int)(unsigned)(size_t)L;
    const float sink2 = sinks_l[h] * LOG2E;
    __syncthreads();
    bf16x8 qr[2][4];
#pragma unroll
    for (int sb = 0; sb < 2; ++sb) { const bf16* Qw = Zb + (size_t)(s0 + 32 * sb + r32) * DIN + C_QA + h * 64 + hi * 8;
#pragma unroll
      for (int d0 = 0; d0 < 4; ++d0) qr[sb][d0] = *(const GAS bf16x8*)(Qw + d0 * 16); }
    float m_reg[2] = {-1e30f, -1e30f}, l_reg[2] = {0.f, 0.f}; f32x16 o[2][2];
#pragma unroll
    for (int sb = 0; sb < 2; ++sb) { o[sb][0] = f32x16{}; o[sb][1] = f32x16{}; }
    TileRegs<64> kr, vr;
    tile_load<64>(kr, Kg, DIN, tid); tile_load<64>(vr, Vg, DIN, tid);
    tile_write_k<64>(kr, L, tid); tile_write_v<2>(vr, L + 16384, tid);
    __syncthreads();
#pragma unroll 1
    for (int j = 0; j < NT; ++j) {
        const int cur = j & 1;
        if (j + 1 < NT) { tile_load<64>(kr, Kg + (size_t)(j + 1) * 64 * DIN, DIN, tid); tile_load<64>(vr, Vg + (size_t)(j + 1) * 64 * DIN, DIN, tid); }
#pragma unroll
        for (int sb = 0; sb < 2; ++sb) {
            f32x16 p0, p1; qkt<64>(p0, p1, L + cur * 8192, qr[sb], r32, hi);
            int rr_ = r32 - 4 * hi; asm volatile("" : "+v"(rr_));
            const int base = s0 + 32 * sb - 64 * (j0 + j) + 63 + rr_;
#pragma unroll
            for (int r = 0; r < 16; ++r) { const int i0 = base - ((r & 3) + 8 * (r >> 2)), i1 = i0 - 32; p0[r] += tbl[i0 > 222 ? 222 : i0]; p1[r] += tbl[i1 > 222 ? 222 : i1]; }
            float alpha; bf16x8 pa0, pa1, pa2, pa3;
            softmax_tile(p0, p1, m_reg[sb], l_reg[sb], alpha, pa0, pa1, pa2, pa3);
            rescale_o<2>(o[sb], alpha, al_l, r32, hi);
            const int vb = lbase + 16384 + cur * 8192 + v_rd_base(lane);
            pv_pipe2<2>(o[sb], vb, pa0, pa1, pa2, pa3);
        }
        if (j + 1 < NT) { tile_write_k<64>(kr, L + (cur ^ 1) * 8192, tid); tile_write_v<2>(vr, L + 16384 + (cur ^ 1) * 8192, tid); }
        __syncthreads();
    }
#pragma unroll
    for (int sb = 0; sb < 2; ++sb) {
        float rl[16]; rows_bcast(1.0f / (l_reg[sb] + __builtin_amdgcn_exp2f(sink2 - m_reg[sb])), rl, li_l, r32, hi);
        int lane_e = lane; asm volatile("" : "+v"(lane_e)); const float cs[2] = {1.f, 1.f};
        if (O8) store_rows_f8<2>(L + wid * 4096, o[sb], rl, OC8_SCALE, O8 + ((size_t)b * SEQ + s0 + 32 * sb) * LDC8 + h * 64, LDC8, lane_e);
        else store_rows<2, PROBE_QOA>(L + wid * 4096, o[sb], rl, cs, Ob + ((size_t)b * SEQ + s0 + 32 * sb) * ldo + h * 64, ldo, lane_e);
    }
}
__device__ __forceinline__ void mem_unit(Frame& F, int b, int hc, int qb, bf16* Ob, size_t ldo, unsigned char* O8) {
    using namespace att;
    const int tid_ = lane_now() + 64 * F.wave;
    const int tid = tid_, lane = tid & 63, wid = F.wave, r32 = lane & 31, hi = lane >> 5, rw = wid & 3, vh = wid >> 2;
    LAS unsigned char* L = F.lds;
    LAS float* al_l = (LAS float*)(L + SCR_OFF + wid * 256); LAS float* li_l = al_l + 32;
    const int qw = qb * 128 + 32 * rw;
    const bf16* Zb = WSP(WS_Z) + (size_t)b * SEQ * DIN;
    const bf16* Kg = WSP(WS_MKV) + (size_t)b * NMEM * 2048 + hc * 256; const bf16* Vg = Kg + 1024;
    const int lbase = (int)(unsigned)(size_t)L;
    __syncthreads();
    bf16x8 qr[16];
    { const bf16* Qw = Zb + (size_t)(qw + r32) * DIN + C_QC + hc * 256 + hi * 8;
#pragma unroll
      for (int d0 = 0; d0 < 16; ++d0) qr[d0] = *(const GAS bf16x8*)(Qw + d0 * 16); }
    float m_reg = -1e30f, l_reg = 0.f; f32x16 o[4];
#pragma unroll
    for (int d = 0; d < 4; ++d) o[d] = f32x16{};
    TileRegs<256> sr;
    tile_load<256>(sr, Kg, 2048, tid); tile_write_k<256>(sr, L, tid);
    tile_load<256>(sr, Vg, 2048, tid); tile_write_v<8>(sr, L + 65536, tid);
    __syncthreads();
#pragma unroll 1
    for (int j = 0; j < 4; ++j) {
        const int cur = j & 1;
        if (j + 1 < 4) tile_load<256>(sr, Kg + (size_t)(j + 1) * 64 * 2048, 2048, tid);
        f32x16 p0, p1; qkt<256>(p0, p1, L + cur * 32768, qr, r32, hi);
        if (j + 1 < 4) { tile_write_k<256>(sr, L + (cur ^ 1) * 32768, tid); tile_load<256>(sr, Vg + (size_t)(j + 1) * 64 * 2048, 2048, tid); }
        float alpha; bf16x8 pa0, pa1, pa2, pa3;
        softmax_tile(p0, p1, m_reg, l_reg, alpha, pa0, pa1, pa2, pa3);
        rescale_o<4>(o, alpha, al_l, r32, hi);
        const int vb = lbase + 65536 + cur * 32768 + vh * 2048 + v_rd_base(lane);
        pv_pipe4<8>(o, vb, pa0, pa1, pa2, pa3);
        if (j + 1 < 4) tile_write_v<8>(sr, L + 65536 + (cur ^ 1) * 32768, tid);
        __syncthreads();
    }
    float rl[16]; rows_bcast(1.0f / l_reg, rl, li_l, r32, hi);
    { int lane_e = lane; asm volatile("" : "+v"(lane_e)); const float cs[4] = {1.f, 1.f, 1.f, 1.f};
      store_rows<4, PROBE_QOC>(L + wid * 8192, o, rl, cs, Ob + ((size_t)b * SEQ + qw) * ldo + hc * 256 + vh * 128, ldo, lane_e);
      if (O8) store_rows_f8<4>(L + wid * 8192, o, rl, OC8_SCALE, O8 + ((size_t)b * SEQ + qw) * LDC8 + hc * 256 + vh * 128, LDC8, lane_e); }
}
struct Args { const float* in[20]; float* out; unsigned char* ws; };
__global__ void __launch_bounds__(NWAVES * 64, 2) mk_fwd(Args args) {
    extern __shared__ __attribute__((aligned(16))) unsigned char lds[];
    Frame F;
    F.lds = (LAS unsigned char*)lds;
    F.MISC = (volatile LAS unsigned*)(F.lds + MISC_OFF);
    F.tid = threadIdx.x; F.lane = F.tid & 63; F.wave = __builtin_amdgcn_readfirstlane(F.tid >> 6);
    F.G = gridDim.x; { const int bx = blockIdx.x; F.bx = bx; F.vcu = (F.G % 8 == 0) ? (bx % 8) * (F.G / 8) + bx / 8 : bx; }
    F.ws = args.ws; F.out = args.out; F.karg = __builtin_amdgcn_kernarg_segment_ptr();
    F.ctl = (gu32*)(F.ws + WS_CTL);
    for (int u = F.tid; u < (LDS_BYTES - LDSCTL_OFF) / 4; u += NWAVES * 64) ((LAS unsigned*)(F.lds + LDSCTL_OFF))[u] = 0u;
    __syncthreads();
    XcdBarrier bar = xcd_barrier_post((unsigned*)(F.ctl + CW_BAR), F.MISC + 8);
#if defined(PROBE_TRACE)
#define TRACE_P ((GAS unsigned long long*)(F.ws + WS_END))
#define GRID_BAR_K(k) do { __syncthreads(); if (lane_now() == 0 && F.wave == 0) { TRACE_P[((size_t)F.bx * 64 + (k)) * 2] = rt(); TRACE_P[((size_t)F.bx * 64 + 32 + (k)) * 2] = __builtin_readcyclecounter(); } xcd_barrier(bar); if (lane_now() == 0 && F.wave == 0) { TRACE_P[((size_t)F.bx * 64 + (k)) * 2 + 1] = rt(); TRACE_P[((size_t)F.bx * 64 + 32 + (k)) * 2 + 1] = __builtin_readcyclecounter(); } } while (0)
    if (threadIdx.x == 0) { TRACE_P[((size_t)F.bx * 64 + 63) * 2] = rt(); if (F.bx == 0) pg8::g_tn = 0; }
#else
#define GRID_BAR_K(k) xcd_barrier(bar)
#endif
#define PHASE_BEGIN() do { { int w_ = F.wave; asm volatile("" : "+s"(w_)); F.wave = w_; GAS unsigned* bb_ = (GAS unsigned*)bar.bar; asm volatile("" : "+s"(bb_)); bar.bar = (unsigned*)bb_; } int t_ = lane_now() + 64 * F.wave; F.tid = t_; F.lane = t_ & 63;     \
        GAS unsigned char* w_ = (GAS unsigned char*)args.ws; asm volatile("" : "+s"(w_)); F.ws = (unsigned char*)w_; GAS float* o_ = (GAS float*)args.out; asm volatile("" : "+s"(o_)); F.out = (float*)o_; \
        auto k_ = __builtin_amdgcn_kernarg_segment_ptr(); asm volatile("" : "+s"(k_)); F.karg = k_; \
        int g_ = (int)gridDim.x, bx_ = (int)blockIdx.x; asm volatile("" : "+s"(g_), "+s"(bx_)); F.G = g_; F.bx = bx_; F.vcu = (g_ % 8 == 0) ? (bx_ % 8) * (g_ / 8) + bx_ / 8 : bx_; } while (0)

    for (int l = 0; l < DEPTH; ++l) {
        for (int rep = 0; rep < REP_PA; ++rep) {
        PHASE_BEGIN();
        phase_a(F, l, inp(F, 0));
        GRID_BAR_K(l * 7 + 0);
        }
        for (int rep = 0; rep < REP_PB; ++rep) {
        PHASE_BEGIN();
        {
            pg8::Gemm g{WSP(WS_X), WSP(WS_WIN) + (size_t)C_QB * LDH, DM, LDH, LDH, 0, 0, 0, 0, 0, 1};
            pg8::StaticOrder S; S.init(T, C_QC - C_QB, F.G, F.bx, PB_BF_WGM);
            pg8::EpiZ E{1 << 20, 0, 0, 1.0f, WSP(WS_Z) + C_QB, DIN, inp(F, 5) + (size_t)l * 3 * DM, 1 << 20, nullptr, 0, 1.0f, (const float*)(F.ws + WS_RS1), 1.0f};
            pg8::gemm_phase<pg8::EpiZ, pg8::StaticOrder, true, true>(F.lds + RING_OFF, g, S, E, F.tid);
        }
        {
            pg8::Gemm g{(const bf16*)(F.ws + WS_H8), (const bf16*)(F.ws + WS_W8), DM / 2, LD8 / 2, LD8 / 2, (long)WS_HM - (long)WS_H8, 0, (long)WS_WMEM - (long)WS_W8, 0, 0, 1};
            pg8::TwoGemmOrder S; S.init(T, DIN - C_QC + N8_SWA, F.G, F.bx, PB_F8_WGM); S.init2(TM, 2048);
            pg8::EpiZ E{N8_SWA / 256, (C_QC - N8_SWA) / 256, C_KA / 256, QS_A / W8_SCALE, WSP(WS_Z), DIN, inp(F, 5) + (size_t)l * 3 * DM, (C_GATE - C_QC + N8_SWA) / 256, WSP(WS_MKV), 2048, 1.0f / W8_SCALE, (const float*)(F.ws + WS_RS1), QS_C / W8_SCALE};
            pg8::gemm_phase<pg8::EpiZ, pg8::TwoGemmOrder, true, true, true>(F.lds + RING_OFF, g, S, E, F.tid);
        }
        GRID_BAR_K(l * 7 + 1);
        }
        for (int rep = 0; rep < REP_PC; ++rep) {
        PHASE_BEGIN();
        {
            const float* sinks = inp(F, 6) + l * 16;
            const float lam = TABP[TAB_LAM + l]; const float ln_scale = 1.0f - (0.8f - 0.6f * expf(-0.3f * (float)l));
            const float* subg = inp(F, 11) + l * 128;
#if ATT_STATIC_PRIO
            if (F.wave >= 4) __builtin_amdgcn_s_setprio(1);
#endif
            const bool dmy = rep + 1 < REP_PC;
#if MFMA_DIFF
            for (int xr = 0; xr < XREP_DIFF; ++xr) { PHASE_BEGIN(); for (int u = F.vcu; u < 1024; u += F.G) { const int i = u >> 8, c = u & 255, bh = c >> 1, half = c & 1;
                const int qb = half ? (i == 0 ? 2 : i == 1 ? 5 : i == 2 ? 3 : 4) : (i == 0 ? 0 : i == 1 ? 7 : i == 2 ? 1 : 6);
                diff_unit<XVAR_DIFF>(F, bh >> 3, bh & 7, qb, lam, ln_scale, subg, WSP(WS_H), (size_t)DM); } PHASE_BEGIN(); }
            for (int u = F.vcu; u < 1024; u += F.G) { const int i = u >> 8, c = u & 255, bh = c >> 1, half = c & 1;
                const int qb = half ? (i == 0 ? 2 : i == 1 ? 5 : i == 2 ? 3 : 4) : (i == 0 ? 0 : i == 1 ? 7 : i == 2 ? 1 : 6);
                diff_unit(F, bh >> 3, bh & 7, qb, lam, ln_scale, subg, dmy ? WSP(WS_H) : WSP(WS_Z) + C_QB, dmy ? (size_t)DM : (size_t)DIN); }
#endif
#if defined(PROBE_TRACE)
            if (F.bx == 0 && lane_now() == 0 && F.wave == 0) pg8::g_tu[256 + l * 4 + 0] = rt();
#endif
#if MFMA_SWA
            for (int xr = 0; xr < XREP_SWA; ++xr) for (int u = F.vcu; u < 1024; u += F.G) swa_unit(F, u >> 6, (u >> 5) & 1, u & 31, sinks, WSP(WS_H), (size_t)DM, true, nullptr);
            for (int u = F.vcu; u < 1024; u += F.G) swa_unit(F, u >> 6, (u >> 5) & 1, u & 31, sinks, WSP(WS_H), (size_t)DM, (F.G & 63) != 0 || u == F.vcu, dmy ? nullptr : (unsigned char*)(F.ws + WS_OA8));
#endif
#if defined(PROBE_TRACE)
            if (F.bx == 0 && lane_now() == 0 && F.wave == 0) pg8::g_tu[256 + l * 4 + 1] = rt();
#endif
#if MFMA_MEM
            for (int xr = 0; xr < XREP_MEM; ++xr) for (int u = F.vcu; u < 1024; u += F.G) mem_unit(F, u >> 6, (u >> 4) & 3, u & 15, WSP(WS_H), (size_t)DM, nullptr);
            for (int u = F.vcu; u < 1024; u += F.G) mem_unit(F, u >> 6, (u >> 4) & 3, u & 15, dmy ? WSP(WS_H) : WSP(WS_Z) + C_QC, dmy ? (size_t)DM : (size_t)DIN, dmy ? nullptr : (unsigned char*)(F.ws + WS_OC8));
#endif
#if ATT_STATIC_PRIO
            __builtin_amdgcn_s_setprio(0);
#endif
#if !MFMA_DIFF || !MFMA_SWA || !MFMA_MEM
            __syncthreads();
            LAS float* scr = (LAS float*)(F.lds + RING_OFF + F.wave * 16384);
            const int gw = GW;
#if !MFMA_SWA
            for (int it = gw; it < T * 16; it += NGW) { const int h = it & 15; swa_naive_item(F, it >> 4, h, sinks[h] * LOG2E, scr); }
#endif
#if !MFMA_DIFF
            for (int it = gw; it < T * 8; it += NGW) diff_naive_item(F, it >> 3, it & 7, lam, ln_scale, subg, scr);
#endif
#if !MFMA_MEM
            for (int it = gw; it < T * 4; it += NGW) mem_naive_item(F, it >> 2, it & 3, scr);
#endif
#endif
        }
        GRID_BAR_K(l * 7 + 2);
        }
        for (int rep = 0; rep < REP_PD; ++rep) {
        PHASE_BEGIN();
#if PD_STAGGER_TICKS
        { const unsigned long long te = rt() + (unsigned long long)(((F.vcu >> PD_STAGGER_SHIFT) & 3) * PD_STAGGER_TICKS); while (rt() < te) __builtin_amdgcn_s_sleep(4); }
#endif
        {
            pg8::Gemm g{WSP(WS_Z) + C_QB, WSP(WS_WBR) + (size_t)DM * LDB, BW, DIN, LDB, 0, 0, 0, 0, 0, 1}; pg8::StaticOrder S; S.init(T, DM, F.G, F.bx, PH_WGM);
            pg8::EpiBranch E{WSP(WS_H), LDH, WSP(WS_Z) + C_GATE, DIN, DM, 1, 0, 1, 1.0f};
            pg8::gemm_phase<pg8::EpiBranch, pg8::StaticOrder, true, true>(F.lds + RING_OFF, g, S, E, F.tid);
        }
        {
            pg8::Gemm g{(const bf16*)(F.ws + WS_OA8), (const bf16*)(F.ws + WS_WBR8A), BW / 2, LDC8 / 2, LDC8 / 2, (long)WS_OC8 - (long)WS_OA8, 0, (long)WS_WBR8 - (long)WS_WBR8A, 0, 0, 1}; pg8::BranchOrder<2> S; S.init(T, DM, F.G, F.bx, PH_WGM);
            pg8::EpiBranch E{WSP(WS_H), LDH, WSP(WS_Z) + C_GATE, DIN, DM, 0, 2, 0, 1.0f / (W8_SCALE * OC8_SCALE)};
            pg8::gemm_phase<pg8::EpiBranch, pg8::BranchOrder<2>, true, true, true>(F.lds + RING_OFF, g, S, E, F.tid);
        }
        GRID_BAR_K(l * 7 + 3);
        }
        for (int rep = 0; rep < REP_PE; ++rep) {
        PHASE_BEGIN();
        {
            pg8::Gemm g{WSP(WS_H), WSP(WS_WOUT), DM, LDH, LDH, 0, 0, 0, 0, 0, 1}; pg8::StaticOrder S; S.init(T, DM, F.G, F.bx, PH_WGM);
            pg8::EpiResB<false, false> E{WSP(WS_X), LDH, (float*)(F.ws + WS_SS), nullptr, 0, nullptr};
            pg8::gemm_phase<pg8::EpiResB<false, false>, pg8::StaticOrder, true, true>(F.lds + RING_OFF, g, S, E, F.tid);
        }
        GRID_BAR_K(l * 7 + 4);
        }
        for (int rep = 0; rep < REP_PG; ++rep) {
        PHASE_BEGIN();
        {
            rs_from_ss(F, (float*)(F.ws + WS_RS2));
            pg8::Gemm g{WSP(WS_X), WSP(WS_W1), DM, LDH, LDH, 0, 0, 0, 0, 0, 1}; pg8::StaticOrder S; S.init(T, DFF, F.G, F.bx, GEMM_WGM);
            pg8::EpiUTiled E{WSP(WS_Z), DFF / 64};
            pg8::gemm_phase<pg8::EpiUTiled, pg8::StaticOrder, true, true>(F.lds + RING_OFF, g, S, E, F.tid);
        }
        GRID_BAR_K(l * 7 + 5);
        }
#if defined(PROBE_XG)
        PHASE_BEGIN();
        {
            pg8::Gemm g{WSP(WS_X), WSP(WS_W1), DM, LDH, LDH, 0, 0, 0, 0, 0, PROBE_XG}; pg8::StaticOrder S; S.init(T, DM, F.G, F.bx);
            pg8::EpiUTiled E{(bf16*)(F.ws + 664 * MiB), DM / 64};
            pg8::gemm_phase<pg8::EpiUTiled, pg8::StaticOrder, true, true>(F.lds + RING_OFF, g, S, E, F.tid);
        }
        GRID_BAR_K(l * 7 + 5);
#endif
        for (int rep = 0; rep < REP_PH; ++rep) {
        PHASE_BEGIN();
        {
            pg8::Gemm g{WSP(WS_Z), WSP(WS_W2), DFF, 64, LDU, 0, 0, 0, 256 * 64 * 2, (long)(DFF / 64) * 256 * 64 * 2, 1}; pg8::StaticOrder S; S.init(T, DM, F.G, F.bx, PH_WGM);
            pg8::EpiResB<true, true> E{WSP(WS_X), LDH, (float*)(F.ws + WS_SS), (unsigned char*)(F.ws + WS_H8), LD8, (const float*)(F.ws + WS_RS2)};
            pg8::gemm_phase<pg8::EpiResB<true, true>, pg8::StaticOrder, true, true, false, PH_A_AUX>(F.lds + RING_OFF, g, S, E, F.tid);
        }
        GRID_BAR_K(l * 7 + 6);
        }
    }
    PHASE_BEGIN();
    for (int m = GW; m < T; m += NGW) final_row(F, m, inp(F, 19), F.out + (size_t)m * DM);
#if defined(PROBE_TRACE)
    { const int l = 4; GRID_BAR_K(l * 7 + 0); }
    PHASE_BEGIN();
    if (F.bx == 0) {
        LAS int* sm = (LAS int*)F.lds;
        if (F.tid < 128) sm[F.tid] = (F.tid >= 32 && F.tid < 64) ? 0 : (F.tid == 97 ? (1 << 30) : -(1 << 30));
        if (F.tid < 256) sm[128 + F.tid] = -(1 << 30);
        __syncthreads();
        if (F.tid < 256) { const GAS unsigned long long* tr = TRACE_P + (size_t)F.tid * 128; const unsigned long long ref = TRACE_P[63 * 2] - 100000ull;
            for (int k = 0; k < 29; ++k) { const int a = (int)(tr[2 * k] - ref), lv = (int)(tr[2 * k + 1] - ref);
                __hip_atomic_fetch_max((int*)&sm[k], a, __ATOMIC_RELAXED, __HIP_MEMORY_SCOPE_WORKGROUP); __hip_atomic_fetch_add((int*)&sm[32 + k], a, __ATOMIC_RELAXED, __HIP_MEMORY_SCOPE_WORKGROUP);
                __hip_atomic_fetch_max((int*)&sm[64 + k], lv, __ATOMIC_RELAXED, __HIP_MEMORY_SCOPE_WORKGROUP); }
            for (int k = 0; k < 29; ++k) __hip_atomic_fetch_max((int*)&sm[128 + (F.tid & 7) * 32 + k], (int)(tr[2 * k] - ref), __ATOMIC_RELAXED, __HIP_MEMORY_SCOPE_WORKGROUP);
            const int st = (int)(tr[126] - ref); __hip_atomic_fetch_max((int*)&sm[96], st, __ATOMIC_RELAXED, __HIP_MEMORY_SCOPE_WORKGROUP); __hip_atomic_fetch_min((int*)&sm[97], st, __ATOMIC_RELAXED, __HIP_MEMORY_SCOPE_WORKGROUP); }
        __syncthreads();
        if (F.tid == 0) {
            const unsigned long long ref0 = TRACE_P[63 * 2] - 100000ull;
            float v[2];
            for (int c = 0; c < 2; ++c) { const int kind = c ? PROBE_K2 : PROBE_K1, mask = c ? PROBE_M2 : PROBE_M1; float acc = 0.f;
                for (int k = 0; k < 28; ++k) if ((mask >> (k % 7)) & 1) { const int prev = k ? sm[k - 1] : sm[96];
                    const float D = (float)(sm[k] - prev), I = (float)sm[k] - (float)sm[32 + k] * (1.0f / 256.0f), B = (float)(sm[64 + k] - sm[k]);
                    acc += kind == 0 ? D : kind == 1 ? I : kind == 2 ? B : 0.f; }
                if (kind == 3) acc = (float)(sm[28] - sm[97]);
                if (kind == 4) acc = (float)(sm[28] - sm[27]);
                if (kind == 5) acc = (float)(sm[96] - sm[97]);
                if (kind == 8) for (int l = 0; l < 4; ++l) acc += (float)((int)(pg8::g_tu[59 * l + (mask & 255)] - ref0) - (int)(pg8::g_tu[59 * l + ((mask >> 8) & 255)] - ref0));
                if (kind == 9) for (int l = 0; l < 4; ++l) acc += (float)((int)(pg8::g_tu[59 * l + (mask & 255)] - ref0) - (int)(TRACE_P[(7 * l + ((mask >> 8) & 255)) * 2 + 1] - ref0));
                if (kind == 10) { float dc = 0.f, dt = 0.f; for (int l = 0; l < 4; ++l) { const int k = 7 * l + mask; if (k == 0) continue;
                        dc += (float)(long long)(TRACE_P[(32 + k) * 2] - TRACE_P[(32 + k - 1) * 2 + 1]); dt += (float)(long long)(TRACE_P[k * 2] - TRACE_P[(k - 1) * 2 + 1]); }
                    acc = dc / dt * 100.0f * 100.0f; }
                if (kind == 11) for (int l = 0; l < 4; ++l) { float summax = 0.f, maxsum = 0.f;
                        for (int k = 7 * l + 1; k < 7 * l + 7; ++k) summax += (float)(sm[k] - sm[64 + k - 1]);
                        for (int g = 0; g < 8; ++g) { float sg = 0.f; for (int k = 7 * l + 1; k < 7 * l + 7; ++k) sg += (float)(sm[128 + g * 32 + k] - sm[64 + k - 1]); maxsum = sg > maxsum ? sg : maxsum; }
                        acc += summax - maxsum; }
                if (kind == 12) for (int l = 0; l < 4; ++l) acc += (float)((int)(pg8::g_tu[256 + l * 4 + mask] - ref0) - (int)(TRACE_P[(7 * l + 1) * 2 + 1] - ref0));
                if (kind == 6) acc = (float)(sm[mask] - (mask ? sm[mask - 1] : sm[96]));
                if (kind == 7) acc = (float)sm[mask] - (float)sm[32 + mask] * (1.0f / 256.0f);
                v[c] = acc * 0.01f; }
            const unsigned long long tend = rt() + (unsigned long long)(v[0] * 100.0f * (float)PROBE_MULT);
            while (rt() < tend) __builtin_amdgcn_s_sleep(8); }
    }
#endif
}

extern "C" void kernel_launch(void* const* d_in, const int* in_sizes, int n_in, void* d_out, int out_size, void* d_ws, size_t ws_size, hipStream_t stream) {
    static int grid = 0;
    if (grid == 0) {
        if (n_in != 20 || in_sizes[0] != T * DM || out_size != T * DM || ws_size < WS_END) { fprintf(stderr, "kernel_launch: unexpected shapes (n_in %d, in0 %d, out %d, ws %zu); nothing launched\n", n_in, n_in > 0 ? in_sizes[0] : -1, out_size, ws_size); grid = -1; return; }
        int dev = 0, cus = 0, per_cu = 0;
        if (hipGetDevice(&dev) != hipSuccess || hipDeviceGetAttribute(&cus, hipDeviceAttributeMultiprocessorCount, dev) != hipSuccess) { grid = -1; return; }
        if (hipFuncSetAttribute((const void*)mk_fwd, hipFuncAttributeMaxDynamicSharedMemorySize, LDS_BYTES) != hipSuccess) { fprintf(stderr, "kernel_launch: hipFuncSetAttribute failed\n"); grid = -1; return; }
        if (hipOccupancyMaxActiveBlocksPerMultiprocessor(&per_cu, (const void*)mk_fwd, NWAVES * 64, LDS_BYTES) != hipSuccess || per_cu < 1) fprintf(stderr, "kernel_launch: occupancy query reports %d\n", per_cu);
        (void)hipGetLastError();
        grid = cus;
    }
    if (grid < 0) return;
    if (hipMemsetAsync((char*)d_ws + WS_CTL, 0, CTL_ZERO_BYTES, stream) != hipSuccess) return;
    Args a{};
    for (int i = 0; i < 20; ++i) a.in[i] = (const float*)d_in[i];
    a.out = (float*)d_out; a.ws = (unsigned char*)d_ws;
    hipLaunchKernelGGL(mk_fwd, dim3(grid), dim3(NWAVES * 64), LDS_BYTES, stream, a);
    const hipError_t le = hipPeekAtLastError();
    if (le != hipSuccess) fprintf(stderr, "kernel_launch: launch failed: %s\n", hipGetErrorName(le));
}
```
